# Optimizing an MI355X kernel written in HIP

```python
import jax, jax.numpy as jnp
from jax import lax
import numpy as np

D_MODEL = 1024
BATCH = 8
SEQ = 4096
DEPTH = 2

N_MIXERS = 2
EPS = 1e-6

N_MEM = 256
MEM_HEADS = 4
MEM_HEAD_DIM = 64
MEM_WIDTH = MEM_HEADS * MEM_HEAD_DIM
MIX_WIDTH = D_MODEL - MEM_WIDTH

ML_HEADS = 4
ML_V_DIM = MIX_WIDTH // ML_HEADS
ML_QK_DIM = ML_V_DIM // 2
ML_CONV = 4
ML_CHUNK = 128
ML_IN_WIDTH = 2 * ML_HEADS * ML_QK_DIM + 2 * MIX_WIDTH + 2 * ML_HEADS + MEM_WIDTH

MLA_HEADS = 12
MLA_NOPE = 64
MLA_ROPE = 32
MLA_V = MIX_WIDTH // MLA_HEADS
MLA_Q_RANK = 384
MLA_KV_RANK = 256
MLA_IN_WIDTH = MLA_Q_RANK + MLA_KV_RANK + MLA_ROPE + MEM_WIDTH
ROPE_THETA = 10000.0
Q_BLOCK = 128

D_FF = 4 * D_MODEL

kernel_name = 'hybrid_mlstm_mla_memory_trunk'

F32 = jnp.float32


def rms_norm(x, g):
    xf = x.astype(F32)
    y = xf * lax.rsqrt(jnp.mean(xf * xf, axis=-1, keepdims=True) + EPS)
    return (y * g.astype(F32)).astype(x.dtype)


def squared_relu_mlp(h, w1, w2):
    return jnp.square(jax.nn.relu(h @ w1)) @ w2


def memory_cross_attention(q_mem, mem_k, mem_v):
    B, S, _ = q_mem.shape
    q = q_mem.reshape(B, S, MEM_HEADS, MEM_HEAD_DIM)
    s = jnp.einsum('bqhd,bmhd->bhqm', q, mem_k).astype(F32) * (MEM_HEAD_DIM ** -0.5)
    p = jax.nn.softmax(s, axis=-1).astype(mem_v.dtype)
    o = jnp.einsum('bhqm,bmhd->bqhd', p, mem_v)
    return o.reshape(B, S, MEM_WIDTH)


def causal_short_conv(x, w):
    K = w.shape[0]
    S = x.shape[1]
    xp = jnp.pad(x, ((0, 0), (K - 1, 0), (0, 0)))
    return sum(xp[:, j:j + S] * w[j] for j in range(K))


def mlstm_chunkwise(q, k, v, log_i, log_f):
    B, S, H, dk = q.shape
    dv = v.shape[-1]
    L = ML_CHUNK
    nc = S // L

    def chunks(t):
        t = t.astype(F32).reshape((B, nc, L) + t.shape[2:])
        return jnp.moveaxis(t, 1, 0).swapaxes(2, 3)

    causal = jnp.tril(jnp.ones((L, L), dtype=bool))

    def step(carry, inp):
        C, n, m = carry
        qc, kc, vc, ic, fc = inp
        b = jnp.cumsum(fc, axis=-1)
        log_w = jnp.where(causal, b[..., :, None] - b[..., None, :] + ic[..., None, :], -jnp.inf)
        log_inter = b + m[..., None]
        m_t = jnp.maximum(log_inter, jnp.max(log_w, axis=-1))
        w = jnp.exp(log_w - m_t[..., None])
        a_inter = jnp.exp(log_inter - m_t)
        s = jnp.einsum('bhjd,bhsd->bhjs', qc, kc) * w
        num = jnp.einsum('bhjs,bhsv->bhjv', s, vc) + a_inter[..., None] * jnp.einsum('bhjd,bhdv->bhjv', qc, C)
        den = jnp.sum(s, axis=-1) + a_inter * jnp.einsum('bhjd,bhd->bhj', qc, n)
        h = num / jnp.maximum(jnp.abs(den), jnp.exp(-m_t))[..., None]
        b_end = b[..., -1]
        log_u = b_end[..., None] - b + ic
        m_new = jnp.maximum(b_end + m, jnp.max(log_u, axis=-1))
        u = jnp.exp(log_u - m_new[..., None])
        decay = jnp.exp(b_end + m - m_new)
        uk = kc * u[..., None]
        C = decay[..., None, None] * C + jnp.einsum('bhsd,bhsv->bhdv', uk, vc)
        n = decay[..., None] * n + jnp.sum(uk, axis=2)
        return (C, n, m_new), h

    init = (jnp.zeros((B, H, dk, dv), F32), jnp.zeros((B, H, dk), F32), jnp.zeros((B, H), F32))
    _, hs = lax.scan(step, init, (chunks(q), chunks(k), chunks(v), chunks(log_i), chunks(log_f)))
    return jnp.moveaxis(hs.swapaxes(2, 3), 0, 1).reshape(B, S, H, dv)


def mlstm_mixer(h, mem_k, mem_v, w_in, b_igate, b_fgate, w_conv, w_hnorm, w_out):
    B, S, _ = h.shape
    qk_w = 2 * ML_HEADS * ML_QK_DIM
    cuts = [qk_w, qk_w + MIX_WIDTH, qk_w + 2 * MIX_WIDTH,
            qk_w + 2 * MIX_WIDTH + ML_HEADS, qk_w + 2 * MIX_WIDTH + 2 * ML_HEADS]
    qk, v, o_pre, i_pre, f_pre, q_mem = jnp.split(h @ w_in, cuts, axis=-1)
    qk = jax.nn.silu(causal_short_conv(qk, w_conv))
    q, k = jnp.split(qk, 2, axis=-1)
    q = q.reshape(B, S, ML_HEADS, ML_QK_DIM)
    k = k.reshape(B, S, ML_HEADS, ML_QK_DIM) * (ML_QK_DIM ** -0.5)
    v = v.reshape(B, S, ML_HEADS, ML_V_DIM)
    log_i = (i_pre + b_igate).astype(F32)
    log_f = jax.nn.log_sigmoid((f_pre + b_fgate).astype(F32))
    h_cell = mlstm_chunkwise(q, k, v, log_i, log_f).astype(h.dtype)
    h_cell = rms_norm(h_cell, w_hnorm)
    y_ml = h_cell.reshape(B, S, MIX_WIDTH) * jax.nn.sigmoid(o_pre)
    y_mem = memory_cross_attention(q_mem, mem_k, mem_v)
    return jnp.concatenate([y_ml, y_mem], axis=-1) @ w_out


def rope_cos_sin(positions):
    inv = ROPE_THETA ** (-jnp.arange(0, MLA_ROPE, 2, dtype=F32) / MLA_ROPE)
    ang = positions.astype(F32)[..., None] * inv
    return jnp.cos(ang), jnp.sin(ang)


def apply_rope(x, cos, sin):
    xf = x.astype(F32)
    x1, x2 = jnp.split(xf, 2, axis=-1)
    return jnp.concatenate([x1 * cos - x2 * sin, x2 * cos + x1 * sin], axis=-1).astype(x.dtype)


def mla_causal_attention(q_nope, q_rope, k_nope, k_rope, v):
    B, S, H, _ = q_nope.shape
    nb = S // Q_BLOCK
    scale = (MLA_NOPE + MLA_ROPE) ** -0.5
    k_pos = jnp.arange(S)

    def block(i):
        start = i * Q_BLOCK
        qn = lax.dynamic_slice_in_dim(q_nope, start, Q_BLOCK, axis=1)
        qr = lax.dynamic_slice_in_dim(q_rope, start, Q_BLOCK, axis=1)
        s = (jnp.einsum('bqhd,bkhd->bhqk', qn, k_nope)
             + jnp.einsum('bqhd,bkd->bhqk', qr, k_rope)).astype(F32) * scale
        q_pos = start + jnp.arange(Q_BLOCK)
        s = jnp.where(k_pos[None, :] <= q_pos[:, None], s, -jnp.inf)
        p = jax.nn.softmax(s, axis=-1).astype(v.dtype)
        return jnp.einsum('bhqk,bkhd->bqhd', p, v)

    out = lax.map(block, jnp.arange(nb))
    return jnp.moveaxis(out, 0, 1).reshape(B, S, H * MLA_V)


def mla_mixer(h, cos, sin, mem_k, mem_v, w_in, w_qnorm, w_uq, w_kvnorm, w_ukv, w_out):
    B, S, _ = h.shape
    cuts = [MLA_Q_RANK, MLA_Q_RANK + MLA_KV_RANK, MLA_Q_RANK + MLA_KV_RANK + MLA_ROPE]
    c_q, c_kv, k_rope, q_mem = jnp.split(h @ w_in, cuts, axis=-1)
    q = (rms_norm(c_q, w_qnorm) @ w_uq).reshape(B, S, MLA_HEADS, MLA_NOPE + MLA_ROPE)
    q_nope, q_rope = q[..., :MLA_NOPE], q[..., MLA_NOPE:]
    kv = (rms_norm(c_kv, w_kvnorm) @ w_ukv).reshape(B, S, MLA_HEADS, MLA_NOPE + MLA_V)
    k_nope, v = kv[..., :MLA_NOPE], kv[..., MLA_NOPE:]
    q_rope = apply_rope(q_rope, cos[:, :, None, :], sin[:, :, None, :])
    k_rope = apply_rope(k_rope, cos, sin)
    y_mla = mla_causal_attention(q_nope, q_rope, k_nope, k_rope, v)
    y_mem = memory_cross_attention(q_mem, mem_k, mem_v)
    return jnp.concatenate([y_mla, y_mem], axis=-1) @ w_out


def setup_inputs(seed: int = 0) -> dict:
    key = jax.random.key(seed)
    ks = jax.random.split(key, 32)

    def dense(k, fi, fo):
        return jax.random.normal(k, (fi, fo), F32) * (fi ** -0.5)

    def gain(k, *shape):
        return 1.0 + 0.02 * jax.random.normal(k, shape, F32)

    x = jax.random.normal(ks[0], (BATCH, SEQ, D_MODEL), F32)
    mem = jax.random.normal(ks[1], (BATCH, N_MEM, D_MODEL), F32)
    positions = (jax.random.randint(ks[2], (BATCH, 1), 0, 1024, dtype=jnp.int32)
                 + jnp.arange(SEQ, dtype=jnp.int32)[None, :])
    return {
        'x': x,
        'mem': mem,
        'positions': positions,
        'mem_norm': gain(ks[3], D_MODEL),
        'w_mem_kv': dense(ks[4], D_MODEL, 2 * MEM_WIDTH),
        'norm_mix0': gain(ks[5], D_MODEL),
        'w_in0': dense(ks[6], D_MODEL, ML_IN_WIDTH),
        'b_igate0': 0.1 * jax.random.normal(ks[7], (ML_HEADS,), F32),
        'b_fgate0': jnp.linspace(3.0, 6.0, ML_HEADS, dtype=F32) + 0.1 * jax.random.normal(ks[8], (ML_HEADS,), F32),
        'w_conv0': jax.random.normal(ks[9], (ML_CONV, 2 * ML_HEADS * ML_QK_DIM), F32) * (ML_CONV ** -0.5),
        'w_hnorm0': gain(ks[10], ML_HEADS, ML_V_DIM),
        'w_out0': dense(ks[11], D_MODEL, D_MODEL),
        'norm_ffn0': gain(ks[12], D_MODEL),
        'w_ff1_0': dense(ks[13], D_MODEL, D_FF),
        'w_ff2_0': dense(ks[14], D_FF, D_MODEL),
        'norm_mix1': gain(ks[15], D_MODEL),
        'w_in1': dense(ks[16], D_MODEL, MLA_IN_WIDTH),
        'w_qnorm1': gain(ks[17], MLA_Q_RANK),
        'w_uq1': dense(ks[18], MLA_Q_RANK, MLA_HEADS * (MLA_NOPE + MLA_ROPE)),
        'w_kvnorm1': gain(ks[19], MLA_KV_RANK),
        'w_ukv1': dense(ks[20], MLA_KV_RANK, MLA_HEADS * (MLA_NOPE + MLA_V)),
        'w_out1': dense(ks[21], D_MODEL, D_MODEL),
        'norm_ffn1': gain(ks[22], D_MODEL),
        'w_ff1_1': dense(ks[23], D_MODEL, D_FF),
        'w_ff2_1': dense(ks[24], D_FF, D_MODEL),
        'final_norm': gain(ks[25], D_MODEL),
    }


def reference(x, mem, positions, mem_norm, w_mem_kv,
              norm_mix0, w_in0, b_igate0, b_fgate0, w_conv0, w_hnorm0, w_out0,
              norm_ffn0, w_ff1_0, w_ff2_0,
              norm_mix1, w_in1, w_qnorm1, w_uq1, w_kvnorm1, w_ukv1, w_out1,
              norm_ffn1, w_ff1_1, w_ff2_1, final_norm):
    Bm = mem.shape[0]
    mem_k, mem_v = jnp.split(rms_norm(mem, mem_norm) @ w_mem_kv, 2, axis=-1)
    mem_k = mem_k.reshape(Bm, N_MEM, MEM_HEADS, MEM_HEAD_DIM)
    mem_v = mem_v.reshape(Bm, N_MEM, MEM_HEADS, MEM_HEAD_DIM)
    cos, sin = rope_cos_sin(positions)
    ffn_params = [(norm_ffn0, w_ff1_0, w_ff2_0), (norm_ffn1, w_ff1_1, w_ff2_1)]
    for layer in range(DEPTH):
        if layer % N_MIXERS == 0:
            x = x + mlstm_mixer(rms_norm(x, norm_mix0), mem_k, mem_v,
                                w_in0, b_igate0, b_fgate0, w_conv0, w_hnorm0, w_out0)
        else:
            x = x + mla_mixer(rms_norm(x, norm_mix1), cos, sin, mem_k, mem_v,
                              w_in1, w_qnorm1, w_uq1, w_kvnorm1, w_ukv1, w_out1)
        g, w1, w2 = ffn_params[layer]
        x = x + squared_relu_mlp(rms_norm(x, g), w1, w2)
    return rms_norm(x, final_norm)
```

```cpp
#include <hip/hip_runtime.h>
#include <hip/hip_cooperative_groups.h>
#include <cstdio>
#include <cstdint>
namespace cg = cooperative_groups;
constexpr float RMS_EPS = 1e-6f;
#ifndef MK_MULTI
#define MK_MULTI 0
#endif
#ifndef PROBE_MASK
#define PROBE_MASK 0
#endif
struct KArgs { const float* in[26]; float* out; unsigned char* ws; int ph_lo, ph_hi; };
namespace pg8 {
#define PG8_LAS __attribute__((address_space(3)))
typedef unsigned short bf16_t;
typedef short bf16x8 __attribute__((ext_vector_type(8)));
typedef float f32x4 __attribute__((ext_vector_type(4)));
typedef unsigned u32x4 __attribute__((ext_vector_type(4)));
constexpr int BM = 256, BK = 64, HALF = 128, HTB = HALF * BK * 2  , STAGE_BYTES = 8 * HTB, NXCD = 8, WGM = 8;

__host__ __device__ __forceinline__ int lds_byte(int r, int c) { const int st = (r >> 4) * 2 + (c >> 5), rr = r & 15, cc = c & 31, ob = rr * 64 + cc * 2; return st * 1024 + (ob ^ (((ob >> 9) & 1) << 5)); }
__host__ __device__ __forceinline__ void stage_rc(int b, int& R, int& C) { const int st = b / 1024, sb = b % 1024, swz = sb ^ (((sb >> 9) & 1) << 5); R = (st >> 1) * 16 + swz / 64; C = (st & 1) * 32 + (swz % 64) / 2; }
__host__ __device__ __forceinline__ int perm32(int rho) { const int n = rho >> 4, i = rho & 15; return 8 * (i >> 2) + 4 * n + (i & 3); }

struct Unit { int pm, pn; };
struct Gemm { const bf16_t* A; const bf16_t* Bt; int M, N, K, lda; };

struct StaticOrder {
    int nM, nN, nwg, G, c, inv;
    __host__ __device__ void init(int M, int N, int G_, int c_) { nM = M / BM; nN = N / BM; nwg = nM * nN; G = G_; c = c_; inv = ((1 << 20) + WGM * nN - 1) / (WGM * nN); }
    __host__ __device__ bool next(int i, Unit& u) const {
        const long L = (long)i * G + c; if (L >= nwg) return false;
        int wgid = (int)L; { const int q = nwg / NXCD, r = nwg % NXCD, xcd = wgid % NXCD, off = wgid / NXCD; wgid = (xcd < r ? xcd * (q + 1) : r * (q + 1) + (xcd - r) * q) + off; }
        const int nig = WGM * nN, gid = (int)(((unsigned)wgid * (unsigned)inv) >> 20), rem = wgid - gid * nig, fm = gid * WGM, gsz = (nM - fm) < WGM ? (nM - fm) : WGM;
        if (gsz == WGM) { u.pm = fm + (rem & (WGM - 1)); u.pn = rem >> 3; }
        else { u.pm = fm + (rem % gsz); u.pn = rem / gsz; }
        return true;
    }
    __device__ __forceinline__ void a_ready(const Unit&) const {}
    __device__ __forceinline__ void done(const Unit&) const {}
};

__device__ __forceinline__ unsigned cvt_pk_bf16(float lo, float hi) { unsigned r; asm volatile("v_cvt_pk_bf16_f32 %0, %1, %2" : "=v"(r) : "v"(lo), "v"(hi)); return r; }

constexpr size_t EP_CS = 2u << 20, EP_MEMKV = 8u << 20, EP_XB = 64u << 20, EP_BIG = 232u << 20; constexpr int EP_T = 32768;
struct Epi {
    static constexpr bool PERM = true, AFTER_DRAIN = false;
    int job; unsigned char* ws; const KArgs& ka;
    template <int MODE> __device__ __forceinline__ void body(const f32x4 (&acc)[2][2][4][2], const Unit& u, int wr, int wc, int fr, int fq,
            int ldc, bf16_t* O, const float* rowsq, float inv_n, float oscale, float* sqA, float* sqB, const float* cs, const float* xold, float* xnew) const {
        const int row0 = u.pm * BM + wr * 64 + fr, col0 = u.pn * BM + wc * 32 + 8 * fq;
        float rsv[8];
#pragma unroll
        for (int r8 = 0; r8 < 8; ++r8) rsv[r8] = (MODE != 3) ? rowsq[row0 + (r8 >> 2) * HALF + (r8 & 3) * 16] : 0.f;
        f32x4 xn[2][2];
        if (MODE == 3) {
#pragma unroll
            for (int bj = 0; bj < 2; ++bj) { const float* xp = xold + (size_t)row0 * ldc + col0 + bj * HALF; xn[bj][0] = *(const f32x4*)xp; xn[bj][1] = *(const f32x4*)(xp + 4); }
        }
#pragma unroll
        for (int ai = 0; ai < 2; ++ai)
#pragma unroll
            for (int m = 0; m < 4; ++m) {
                const int row = row0 + ai * HALF + m * 16;
                float rs = 1.f;
                if (MODE != 3) rs = rsqrtf(rsv[ai * 4 + m] * inv_n + RMS_EPS) * oscale;
                f32x4 xc[2][2];
                if (MODE == 3) {
#pragma unroll
                    for (int bj = 0; bj < 2; ++bj) { xc[bj][0] = xn[bj][0]; xc[bj][1] = xn[bj][1]; }
                    if (ai * 4 + m < 7) { const int rown = row0 + ((ai * 4 + m + 1) >> 2) * HALF + ((ai * 4 + m + 1) & 3) * 16;
#pragma unroll
                        for (int bj = 0; bj < 2; ++bj) { const float* xp = xold + (size_t)rown * ldc + col0 + bj * HALF; xn[bj][0] = *(const f32x4*)xp; xn[bj][1] = *(const f32x4*)(xp + 4); } }
                }
                float ss[2];
#pragma unroll
                for (int bj = 0; bj < 2; ++bj) {
                    const int col = col0 + bj * HALF;
                    f32x4 v0 = acc[ai][bj][m][0] * rs, v1 = acc[ai][bj][m][1] * rs;
                    if (MODE == 3) {
                        v0 = v0 + xc[bj][0]; v1 = v1 + xc[bj][1];
                        *(f32x4*)(xnew + (size_t)row * ldc + col) = v0; *(f32x4*)(xnew + (size_t)row * ldc + col + 4) = v1;
                    }
                    if (MODE == 4) {
#pragma unroll
                        for (int e = 0; e < 4; ++e) { const float a = fmaxf(v0[e], 0.f), b = fmaxf(v1[e], 0.f); v0[e] = a * a; v1[e] = b * b; }
                    }
                    ss[bj] = (v0[0] * v0[0] + v0[1] * v0[1]) + (v0[2] * v0[2] + v0[3] * v0[3]) + (v1[0] * v1[0] + v1[1] * v1[1]) + (v1[2] * v1[2] + v1[3] * v1[3]);
                    bool rope = false; int p = 0;
                    if (MODE == 1) { rope = (u.pn == 2 && bj == 1 && wc == 0); p = 4 * fq; }
                    if (MODE == 2) { const int j = col % 96; rope = (j >= 64) && (col < 1152); p = (j - 64) >> 1; }
                    if (rope) {
                        const f32x4 c0 = *(const f32x4*)(cs + (size_t)row * 32 + 2 * p), c1 = *(const f32x4*)(cs + (size_t)row * 32 + 2 * p + 4);
                        f32x4 r0, r1;
                        r0[0] = v0[0] * c0[0] - v0[1] * c0[1]; r0[1] = v0[1] * c0[0] + v0[0] * c0[1];
                        r0[2] = v0[2] * c0[2] - v0[3] * c0[3]; r0[3] = v0[3] * c0[2] + v0[2] * c0[3];
                        r1[0] = v1[0] * c1[0] - v1[1] * c1[1]; r1[1] = v1[1] * c1[0] + v1[0] * c1[1];
                        r1[2] = v1[2] * c1[2] - v1[3] * c1[3]; r1[3] = v1[3] * c1[2] + v1[2] * c1[3];
                        v0 = r0; v1 = r1;
                    }
                    u32x4 w; w.x = cvt_pk_bf16(v0[0], v0[1]); w.y = cvt_pk_bf16(v0[2], v0[3]); w.z = cvt_pk_bf16(v1[0], v1[1]); w.w = cvt_pk_bf16(v1[2], v1[3]);
                    if (job != 10) *(u32x4*)(O + (size_t)row * ldc + col) = w;
                }
                if (MODE == 1 || MODE == 3) {
                    float s = ss[0] + ((MODE == 3 || u.pn != 2) ? ss[1] : 0.f);
                    { const auto r = __builtin_amdgcn_permlane16_swap(__float_as_uint(s), __float_as_uint(s), false, false); s = __uint_as_float(r[0]) + __uint_as_float(r[1]); }
                    { const auto r = __builtin_amdgcn_permlane32_swap(__float_as_uint(s), __float_as_uint(s), false, false); s = __uint_as_float(r[0]) + __uint_as_float(r[1]); }
                    if (fq == 0) {
                        if (MODE == 3) unsafeAtomicAdd(sqA + row, s);
                        else { if (u.pn == 0) unsafeAtomicAdd(sqA + row, s); else if (u.pn == 1 || u.pn == 2) unsafeAtomicAdd(sqB + row, s); }
                    }
                }
            }
    }
    __device__ __forceinline__ void operator()(const f32x4 (&acc)[2][2][4][2], const Unit& u, int wr, int wc, int fr, int fq) const {
        float* rsq = (float*)ws; const float* cs = (const float*)(ws + EP_CS); float* xo = ka.out;
        bf16_t* OB = (bf16_t*)(ws + EP_BIG); bf16_t* OX = (bf16_t*)(ws + EP_XB);
        const float kq = 0.10206207261596575f * 1.4426950408889634f;
#define EPI_CALL(MODE_, LDC_, O_, RSQ_, INVN_, OSC_, SQA_, SQB_, XOLD_) body<MODE_>(acc, u, wr, wc, fr, fq, LDC_, O_, RSQ_, INVN_, OSC_, SQA_, SQB_, cs, XOLD_, xo)
        switch (job) {
            case 0: EPI_CALL(0, 2560, OB, rsq, 1.f / 1024.f, 1.f, nullptr, nullptr, xo); break;
            case 1: EPI_CALL(0, 512, (bf16_t*)(ws + EP_MEMKV), rsq + 7 * EP_T, 1.f / 1024.f, 1.f, nullptr, nullptr, xo); break;
            case 2: EPI_CALL(3, 1024, OX, rsq, 1.f / 1024.f, 1.f, rsq + 1 * EP_T, nullptr, ka.in[0]); break;
            case 3: EPI_CALL(4, 4096, OB, rsq + 1 * EP_T, 1.f / 1024.f, 1.f, nullptr, nullptr, xo); break;
            case 4: EPI_CALL(3, 1024, OX, rsq, 1.f / 1024.f, 1.f, rsq + 2 * EP_T, nullptr, xo); break;
            case 5: EPI_CALL(1, 1024, OB, rsq + 2 * EP_T, 1.f / 1024.f, 1.f, rsq + 6 * EP_T, rsq + 5 * EP_T, xo); break;
            case 6: EPI_CALL(2, 1280, OB + (32u << 20), rsq + 5 * EP_T, 1.f / 384.f, kq, nullptr, nullptr, xo); break;
            case 7: EPI_CALL(0, 1536, OB + (72u << 20), rsq + 6 * EP_T, 1.f / 256.f, 1.f, nullptr, nullptr, xo); break;
            case 8: EPI_CALL(3, 1024, OX, rsq, 1.f / 1024.f, 1.f, rsq + 3 * EP_T, nullptr, xo); break;
            case 9: EPI_CALL(4, 4096, OB, rsq + 3 * EP_T, 1.f / 1024.f, 1.f, nullptr, nullptr, xo); break;
            default: EPI_CALL(3, 1024, OX, rsq, 1.f / 1024.f, 1.f, rsq + 4 * EP_T, nullptr, xo); break;
        }
#undef EPI_CALL
    }
};
template <class Epi, class Sched, bool ALIGN_EPI = false, bool SP2 = false>
__device__ __forceinline__ void gemm_phase(PG8_LAS unsigned char* lds, const Gemm g, const Sched& S, const Epi& E) {
    int tid_ = threadIdx.x; asm volatile("" : "+v"(tid_));
    const int tid = tid_, wid = __builtin_amdgcn_readfirstlane(tid >> 6), lane = tid & 63, wr = wid >> 2, wc = wid & 3, fr = lane & 15, fq = lane >> 4;
    const int K = g.K, nt = K / BK;
    unsigned voffA[2], voffB[2];
#pragma unroll
    for (int i = 0; i < 2; ++i) { int R, C; stage_rc(tid * 16 + i * 8192, R, C); const int Rb = Epi::PERM ? ((R & ~31) + perm32(R & 31)) : R;
        voffA[i] = (unsigned)(R * g.lda + C) * 2u; voffB[i] = (unsigned)(Rb * K + C) * 2u; }
    const size_t kstep = (size_t)(BK * 2);
    const size_t hstepB = (size_t)HALF * K * 2, hstepA = (size_t)HALF * g.lda * 2;
    const size_t tstepB = 2 * hstepB, tstepA = 2 * hstepA;
    const unsigned ldsw = (unsigned)wid * 1024u;
    const int aoff = lds_byte(wr * 64 + fr, fq * 8), boff = lds_byte(wc * 32 + fr, fq * 8);
#define PG8_SA(b, h) (((b) * 2 + (h)) * HTB)
#define PG8_SB(b, h) ((4 + (b) * 2 + (h)) * HTB)
#define PG8_STAGE(bufoff, gbase, voff) do { _Pragma("unroll") for (int _i = 0; _i < 2; ++_i) \
        __builtin_amdgcn_global_load_lds((const unsigned*)((const char*)(gbase) + (voff)[_i]), (PG8_LAS unsigned*)(lds + (bufoff) + ldsw + _i * 8192), 16, 0, 0); } while (0)
#define PG8_LDA(dst, b, h) do { _Pragma("unroll") for (int m = 0; m < 4; ++m) _Pragma("unroll") for (int k = 0; k < 2; ++k) dst[m][k] = *(const PG8_LAS bf16x8*)(lds + PG8_SA(b, h) + aoff + m * 2048 + k * 1024); } while (0)
#define PG8_LDB(dst, b, h) do { _Pragma("unroll") for (int n = 0; n < 2; ++n) _Pragma("unroll") for (int k = 0; k < 2; ++k) dst[n][k] = *(const PG8_LAS bf16x8*)(lds + PG8_SB(b, h) + boff + n * 2048 + k * 1024); } while (0)
#define PG8_MMA(ai, bj, At, Bt) do { __builtin_amdgcn_s_setprio(1); _Pragma("unroll") for (int m = 0; m < 4; ++m) _Pragma("unroll") for (int n = 0; n < 2; ++n) _Pragma("unroll") for (int k = 0; k < 2; ++k) \
        acc[ai][bj][m][n] = __builtin_amdgcn_mfma_f32_16x16x32_bf16(Bt[n][k], At[m][k], acc[ai][bj][m][n], 0, 0, 0); __builtin_amdgcn_s_setprio(0); } while (0)
#define PG8_WAIT_V(n) asm volatile("s_waitcnt vmcnt(" #n ")" ::: "memory")
#define PG8_WAIT_L(n) asm volatile("s_waitcnt lgkmcnt(" #n ")" ::: "memory")
#define PG8_BAR __builtin_amdgcn_s_barrier()
#define PG8_SCHED __builtin_amdgcn_sched_barrier(0)
    Unit cur, nxt; int ui = 0;
    if (!S.next(0, cur)) return;
    f32x4 acc[2][2][4][2];
#pragma unroll
    for (int a = 0; a < 2; ++a)
#pragma unroll
        for (int b = 0; b < 2; ++b)
#pragma unroll
            for (int m = 0; m < 4; ++m)
#pragma unroll
                for (int n = 0; n < 2; ++n) acc[a][b][m][n] = (f32x4){0.f, 0.f, 0.f, 0.f};
    bf16x8 At[4][2], B0[2][2], B1[2][2];
    const char* cA = (const char*)g.A + (size_t)cur.pm * tstepA; const char* cB = (const char*)g.Bt + (size_t)cur.pn * tstepB;
    S.a_ready(cur);
    if constexpr (SP2) {
        PG8_STAGE(PG8_SB(0, 0), cB, voffB); PG8_STAGE(PG8_SB(0, 1), cB + hstepB, voffB); PG8_STAGE(PG8_SA(0, 0), cA, voffA); PG8_STAGE(PG8_SA(0, 1), cA + hstepA, voffA);
        if (wr == 1) PG8_BAR;
        PG8_WAIT_V(2); PG8_BAR;
        PG8_STAGE(PG8_SB(1, 0), cB + kstep, voffB); PG8_STAGE(PG8_SA(1, 0), cA + kstep, voffA); PG8_STAGE(PG8_SB(1, 1), cB + hstepB + kstep, voffB);
        PG8_WAIT_V(6); PG8_BAR;
    } else {
        PG8_STAGE(PG8_SB(0, 0), cB, voffB); PG8_STAGE(PG8_SA(0, 0), cA, voffA); PG8_STAGE(PG8_SB(0, 1), cB + hstepB, voffB); PG8_STAGE(PG8_SA(0, 1), cA + hstepA, voffA);
        if (wr == 1) PG8_BAR;
        PG8_WAIT_V(4); PG8_BAR;
        PG8_STAGE(PG8_SB(1, 0), cB + kstep, voffB); PG8_STAGE(PG8_SA(1, 0), cA + kstep, voffA); PG8_STAGE(PG8_SB(1, 1), cB + hstepB + kstep, voffB);
        PG8_WAIT_V(6); PG8_BAR;
    }
    for (;;) {
        const bool has_next = S.next(ui + 1, nxt);
        const char* nA = has_next ? (const char*)g.A + (size_t)nxt.pm * tstepA : cA; const char* nB = has_next ? (const char*)g.Bt + (size_t)nxt.pn * tstepB : cB;
        for (int t = 0; t < nt; t += 2) {
            const bool last = (t == nt - 2);
            const char* a1 = cA + (size_t)(t + 1) * kstep;
            const char* a2 = last ? nA : cA + (size_t)(t + 2) * kstep; const char* b2 = last ? nB : cB + (size_t)(t + 2) * kstep;
            const char* a3 = a2 + kstep; const char* b3 = b2 + kstep;
            if (last && has_next) S.a_ready(nxt);
            if constexpr (SP2) {
            PG8_LDB(B0, 0, 0); PG8_LDB(B1, 0, 1); PG8_SCHED; PG8_LDA(At, 0, 0); PG8_STAGE(PG8_SA(1, 1), a1 + hstepA, voffA);
            PG8_WAIT_V(8); PG8_WAIT_L(0); PG8_BAR; PG8_MMA(0, 0, At, B0); PG8_MMA(0, 1, At, B1); PG8_BAR; PG8_SCHED;
            PG8_LDA(At, 0, 1); PG8_STAGE(PG8_SB(0, 0), b2, voffB); PG8_STAGE(PG8_SB(0, 1), b2 + hstepB, voffB); PG8_STAGE(PG8_SA(0, 0), a2, voffA);
            PG8_WAIT_V(8); PG8_WAIT_L(0); PG8_BAR; PG8_MMA(1, 0, At, B0); PG8_MMA(1, 1, At, B1); PG8_BAR; PG8_SCHED;
            PG8_LDB(B0, 1, 0); PG8_LDB(B1, 1, 1); PG8_SCHED; PG8_LDA(At, 1, 0); PG8_STAGE(PG8_SA(0, 1), a2 + hstepA, voffA);
            PG8_WAIT_V(8); PG8_WAIT_L(0); PG8_BAR; PG8_MMA(0, 0, At, B0); PG8_MMA(0, 1, At, B1); PG8_BAR; PG8_SCHED;
            PG8_LDA(At, 1, 1); PG8_STAGE(PG8_SB(1, 0), b3, voffB); PG8_STAGE(PG8_SB(1, 1), b3 + hstepB, voffB); PG8_STAGE(PG8_SA(1, 0), a3, voffA);
            PG8_WAIT_V(8); PG8_WAIT_L(0); PG8_BAR; PG8_MMA(1, 0, At, B0); PG8_MMA(1, 1, At, B1); PG8_BAR; PG8_SCHED;
            } else {
            PG8_LDB(B0, 0, 0); PG8_SCHED; PG8_LDA(At, 0, 0); PG8_STAGE(PG8_SA(1, 1), a1 + hstepA, voffA);
            PG8_WAIT_L(8); PG8_BAR; PG8_WAIT_L(0); PG8_MMA(0, 0, At, B0); PG8_BAR; PG8_SCHED;
            PG8_LDB(B1, 0, 1); PG8_STAGE(PG8_SB(0, 0), b2, voffB);
            PG8_BAR; PG8_WAIT_L(0); PG8_MMA(0, 1, At, B1); PG8_BAR;
            PG8_LDA(At, 0, 1); PG8_STAGE(PG8_SA(0, 0), a2, voffA);
            PG8_BAR; PG8_WAIT_L(0); PG8_MMA(1, 0, At, B0); PG8_BAR; PG8_SCHED;
            PG8_STAGE(PG8_SB(0, 1), b2 + hstepB, voffB);
            PG8_WAIT_V(6); PG8_BAR; PG8_MMA(1, 1, At, B1); PG8_BAR;
            PG8_LDB(B0, 1, 0); PG8_SCHED; PG8_LDA(At, 1, 0); PG8_STAGE(PG8_SA(0, 1), a2 + hstepA, voffA);
            PG8_WAIT_L(8); PG8_BAR; PG8_WAIT_L(0); PG8_MMA(0, 0, At, B0); PG8_BAR; PG8_SCHED;
            PG8_LDB(B1, 1, 1); PG8_STAGE(PG8_SB(1, 0), b3, voffB);
            PG8_BAR; PG8_WAIT_L(0); PG8_MMA(0, 1, At, B1); PG8_BAR;
            PG8_LDA(At, 1, 1); PG8_STAGE(PG8_SA(1, 0), a3, voffA);
            PG8_BAR; PG8_WAIT_L(0); PG8_MMA(1, 0, At, B0); PG8_BAR; PG8_SCHED;
            PG8_STAGE(PG8_SB(1, 1), b3 + hstepB, voffB);
            PG8_WAIT_V(6); PG8_BAR; PG8_MMA(1, 1, At, B1); PG8_BAR;
            }
        }
        if constexpr (ALIGN_EPI) { if (wr == 0) PG8_BAR; }
        if constexpr (!Epi::AFTER_DRAIN) { E(acc, cur, wr, wc, fr, fq); S.done(cur); }
        if (!has_next) break;
#pragma unroll
        for (int a = 0; a < 2; ++a)
#pragma unroll
            for (int b = 0; b < 2; ++b)
#pragma unroll
                for (int m = 0; m < 4; ++m)
#pragma unroll
                    for (int n = 0; n < 2; ++n) acc[a][b][m][n] = (f32x4){0.f, 0.f, 0.f, 0.f};
        cur = nxt; cA = nA; cB = nB; ++ui;
        if constexpr (ALIGN_EPI) { if (wr == 1) PG8_BAR; }
    }
    PG8_WAIT_V(0);
    if constexpr (!ALIGN_EPI) { if (wr == 0) PG8_BAR; }
    PG8_BAR;
    if constexpr (Epi::AFTER_DRAIN) { E.fused(acc, cur, wr, wc, fr, fq, lds, wid, lane); S.done(cur); }
#undef PG8_SA
#undef PG8_SB
#undef PG8_STAGE
#undef PG8_LDA
#undef PG8_LDB
#undef PG8_MMA
#undef PG8_WAIT_V
#undef PG8_WAIT_L
#undef PG8_BAR
#undef PG8_SCHED
}
}
#define LAS __attribute__((address_space(3)))
#define DI __device__ __forceinline__
typedef unsigned short bf16;
typedef short bf16x8 __attribute__((ext_vector_type(8)));
typedef short s16x4 __attribute__((ext_vector_type(4)));
typedef float f32x4 __attribute__((ext_vector_type(4)));
typedef unsigned u32x4 __attribute__((ext_vector_type(4)));
typedef unsigned u32x2 __attribute__((ext_vector_type(2)));
constexpr int NTHR = 512, NWAVES = 8;
constexpr int B_ = 8, S_ = 4096, T_ = B_ * S_, D_ = 1024, FF_ = 4096;
constexpr int NMEM = 256, TM_ = B_ * NMEM;
constexpr int P0W = 2560;
constexpr int P1W = 1024;
constexpr int QW = 1280;
constexpr int KVW = 1536;
constexpr int NCH = 32;
constexpr int CT_ROWS = 208;
constexpr size_t MiB = 1u << 20;
constexpr size_t WS_ROWSQ = 0;
constexpr size_t WS_GATES = 1 * MiB;
constexpr size_t WS_CS = 2 * MiB;
constexpr size_t WS_SCAL = 6 * MiB;
constexpr size_t WS_MPREV = 6 * MiB + 65536;
constexpr size_t WS_MEMKV = 8 * MiB;
constexpr size_t WS_MEMBF = 10 * MiB;
constexpr size_t WS_WIN0 = 16 * MiB, WS_WMEM = 21 * MiB, WS_WOUT0 = 22 * MiB, WS_WFF1_0 = 24 * MiB, WS_WFF2_0 = 32 * MiB, WS_WIN1 = 40 * MiB,
                 WS_WUQ = 42 * MiB, WS_WUKV = 43 * MiB, WS_WOUT1 = 44 * MiB, WS_WFF1_1 = 46 * MiB, WS_WFF2_1 = 54 * MiB;
constexpr size_t WS_XB = 64 * MiB;
constexpr size_t WS_Y = 128 * MiB;
constexpr size_t WS_CT = 192 * MiB;
constexpr size_t WS_BIG = 232 * MiB;
constexpr size_t WS_END = 488 * MiB;
constexpr int LDS_BYTES = 147456;

DI float bf2f(unsigned short h) { return __uint_as_float(((unsigned)h) << 16); }
DI unsigned short f2bf(float f) { return __builtin_bit_cast(unsigned short, (__bf16)f); }
typedef float f32x2 __attribute__((ext_vector_type(2)));
typedef __bf16 bf16x2_t __attribute__((ext_vector_type(2)));
DI unsigned pk2(float lo, float hi) { const f32x2 v = {lo, hi}; return __builtin_bit_cast(unsigned, __builtin_convertvector(v, bf16x2_t)); }
DI float wave_sum(float v) {
#pragma unroll
    for (int o = 1; o < 64; o <<= 1) v += __shfl_xor(v, o);
    return v;
}
DI float xor32_max(float x) { const auto r = __builtin_amdgcn_permlane32_swap(__float_as_uint(x), __float_as_uint(x), false, false); return fmaxf(__uint_as_float(r[0]), __uint_as_float(r[1])); }
DI float xor32_sum(float x) { const auto r = __builtin_amdgcn_permlane32_swap(__float_as_uint(x), __float_as_uint(x), false, false); return __uint_as_float(r[0]) + __uint_as_float(r[1]); }
DI float silu(float x) { return x * __builtin_amdgcn_rcpf(1.f + __expf(-x)); }
#define LDS_WAIT() asm volatile("s_waitcnt lgkmcnt(0)" ::: "memory")
#define MFMA16(a, b, c) __builtin_amdgcn_mfma_f32_16x16x32_bf16((a), (b), (c), 0, 0, 0)

typedef KArgs Args;
DI const float* inp(const Args& a, int i) { asm volatile("" : "+s"(i)); return a.in[i]; }
enum { I_X = 0, I_MEM, I_POS, I_MEMNORM, I_WMEMKV, I_NORMMIX0, I_WIN0, I_BI, I_BF, I_WCONV, I_WHNORM, I_WOUT0, I_NORMFFN0, I_WFF1_0, I_WFF2_0,
       I_NORMMIX1, I_WIN1, I_WQNORM, I_WUQ, I_WKVNORM, I_WUKV, I_WOUT1, I_NORMFFN1, I_WFF1_1, I_WFF2_1, I_FINALNORM };

DI int srccol(int map, int n) {
    if (map == 1) return n < 2304 ? n : n + 8;
    if (map == 2) {
        if (n < 256) return 384 + n;
        if (n < 640) return n - 256;
        if (n < 672) { const int j = n - 640; return 640 + (j & 1) * 16 + (j >> 1); }
        if (n < 768) return -1;
        return 672 + (n - 768);
    }
    if (map == 3) {
        if (n >= 1152) return -1;
        const int h = n / 96, j = n % 96;
        if (j < 64) return h * 96 + j;
        const int jj = j - 64; return h * 96 + 64 + (jj & 1) * 16 + (jj >> 1);
    }
    return n;
}
DI void cvt_item(const float* W, int K, int Nsrc, int Ndst, int map, const float* gain, bf16* WT, LAS float* scr, int item, int lane) {
    const int nblk = Ndst / 32, kb = item / nblk, nb = item % nblk, k0 = 64 * kb, n0 = 32 * nb;
    const int sc = srccol(map, n0 + (lane & 31));
    float wv[32];
#pragma unroll
    for (int i = 0; i < 32; ++i) { const int kk = 2 * i + (lane >> 5); wv[i] = (sc >= 0) ? W[(size_t)(k0 + kk) * Nsrc + sc] : 0.f; }
    const int c = lane & 7;
    f32x4 g0 = (f32x4){1.f, 1.f, 1.f, 1.f}, g1 = g0;
    if (gain) { g0 = *(const f32x4*)(gain + k0 + 8 * c); g1 = *(const f32x4*)(gain + k0 + 8 * c + 4); }
#pragma unroll
    for (int i = 0; i < 32; ++i) { const int kk = 2 * i + (lane >> 5); scr[kk * 33 + (lane & 31)] = wv[i]; }
    LDS_WAIT(); asm volatile("" ::: "memory");
#pragma unroll
    for (int j = 0; j < 4; ++j) { const int n = (lane >> 3) + 8 * j; const LAS float* s = scr + (8 * c) * 33 + n;
        u32x4 o; o.x = pk2(s[0 * 33] * g0.x, s[1 * 33] * g0.y); o.y = pk2(s[2 * 33] * g0.z, s[3 * 33] * g0.w); o.z = pk2(s[4 * 33] * g1.x, s[5 * 33] * g1.y); o.w = pk2(s[6 * 33] * g1.z, s[7 * 33] * g1.w);
        *(u32x4*)(WT + (size_t)(n0 + n) * K + k0 + 8 * c) = o; }
    LDS_WAIT(); asm volatile("" ::: "memory");
}
DI float logsigmoid(float z) { return fminf(z, 0.f) - __logf(1.f + __expf(-fabsf(z))); }

DI void p0_prologue(const Args& a, LAS unsigned char* lds, int gw, int NGW, int lane, int wave, int tid) {
    __attribute__((address_space(1))) unsigned char* wsg_ = (__attribute__((address_space(1))) unsigned char*)a.ws; asm volatile("" : "+s"(wsg_)); unsigned char* ws = (unsigned char*)wsg_;
    LAS float* scr = (LAS float*)(lds + wave * 8448);
    LAS float* gwl = (LAS float*)(lds + 73728);
    { const float* W = inp(a, I_WIN0); const float* g = inp(a, I_NORMMIX0);
      for (int e = tid; e < 1024 * 8; e += NTHR) { const int k = e >> 3, c = e & 7; gwl[(((((k >> 8) * 4 + (k & 3)) * 2 + (c >> 2)) * 64 + ((k & 255) >> 2)) << 2) + (c & 3)] = W[(size_t)k * 2568 + 2304 + c] * g[k]; } }
#define CV(W_, K_, NS_, ND_, MAP_, G_, OFF_) { constexpr int items = (K_ / 64) * (ND_ / 32); if (r < items) { cvt_item(inp(a, W_), K_, NS_, ND_, MAP_, (G_) >= 0 ? inp(a, (G_) >= 0 ? (G_) : 0) : nullptr, (bf16*)(ws + OFF_), scr, r, lane); continue; } r -= items; }
    constexpr int NITEMS = 16 * 80 + 16 * 16 + 16 * 32 + 16 * 128 + 64 * 32 + 16 * 32 + 6 * 40 + 4 * 48 + 16 * 32 + 16 * 128 + 64 * 32;
    for (int it = gw; it < NITEMS; it += NGW) {
        int r = it;
        CV(I_WIN0, 1024, 2568, 2560, 1, I_NORMMIX0, WS_WIN0)
        CV(I_WMEMKV, 1024, 512, 512, 0, I_MEMNORM, WS_WMEM)
        CV(I_WOUT0, 1024, 1024, 1024, 0, -1, WS_WOUT0)
        CV(I_WFF1_0, 1024, 4096, 4096, 0, I_NORMFFN0, WS_WFF1_0)
        CV(I_WFF2_0, 4096, 1024, 1024, 0, -1, WS_WFF2_0)
        CV(I_WIN1, 1024, 928, 1024, 2, I_NORMMIX1, WS_WIN1)
        CV(I_WUQ, 384, 1152, 1280, 3, I_WQNORM, WS_WUQ)
        CV(I_WUKV, 256, 1536, 1536, 0, I_WKVNORM, WS_WUKV)
        CV(I_WOUT1, 1024, 1024, 1024, 0, -1, WS_WOUT1)
        CV(I_WFF1_1, 1024, 4096, 4096, 0, I_NORMFFN1, WS_WFF1_1)
        CV(I_WFF2_1, 4096, 1024, 1024, 0, -1, WS_WFF2_1)
    }
#undef CV
    __syncthreads();
    float* rowsq = (float*)(ws + WS_ROWSQ); float* gates = (float*)(ws + WS_GATES);
    const float* bi = inp(a, I_BI); const float* bfg = inp(a, I_BF);
    for (int m0 = gw; m0 < T_; m0 += 2 * NGW) {
        f32x4 xv[2][4];
#pragma unroll
        for (int rr = 0; rr < 2; ++rr) { const int m = min(m0 + rr * NGW, T_ - 1); const f32x4* xr = (const f32x4*)(inp(a, I_X) + (size_t)m * D_) + lane;
#pragma unroll
                for (int j = 0; j < 4; ++j) xv[rr][j] = xr[64 * j]; }
#pragma unroll
        for (int rr = 0; rr < 2; ++rr) { const int m = m0 + rr * NGW; if (m < T_) {
            unsigned long long* o8 = (unsigned long long*)((bf16*)(ws + WS_XB) + (size_t)m * D_) + lane;
            float s = 0.f, g8[8];
#pragma unroll
            for (int j = 0; j < 8; ++j) g8[j] = 0.f;
#pragma unroll
            for (int j = 0; j < 4; ++j) { const f32x4 v = xv[rr][j]; s += (v.x * v.x + v.y * v.y) + (v.z * v.z + v.w * v.w);
                o8[64 * j] = (unsigned long long)pk2(v.x, v.y) | ((unsigned long long)pk2(v.z, v.w) << 32);
                const LAS f32x4* gq = (const LAS f32x4*)gwl + (j * 8) * 64 + lane;
#pragma unroll
                for (int e = 0; e < 4; ++e) { const f32x4 w0 = gq[(2 * e) * 64], w1 = gq[(2 * e + 1) * 64]; const float xe = v[e];
                    g8[0] += xe * w0.x; g8[1] += xe * w0.y; g8[2] += xe * w0.z; g8[3] += xe * w0.w; g8[4] += xe * w1.x; g8[5] += xe * w1.y; g8[6] += xe * w1.z; g8[7] += xe * w1.w; } }
            s = wave_sum(s);
#pragma unroll
            for (int j = 0; j < 8; ++j) g8[j] = wave_sum(g8[j]);
            const float rstd = rsqrtf(s * (1.f / D_) + RMS_EPS);
            if (lane == 0) rowsq[m] = s;
            if (lane < 8) { float gv = g8[0];
#pragma unroll
                for (int j = 1; j < 8; ++j) gv = (lane == j) ? g8[j] : gv;
                gv *= rstd;
                gates[(size_t)m * 8 + lane] = (lane < 4) ? gv + bi[lane] : logsigmoid(gv + bfg[lane - 4]); }
        } }
    }
    for (int m = gw; m < TM_; m += NGW) {
        const f32x4* xr = (const f32x4*)(inp(a, I_MEM) + (size_t)m * D_) + lane;
        unsigned long long* o8 = (unsigned long long*)((bf16*)(ws + WS_MEMBF) + (size_t)m * D_) + lane;
        float s = 0.f;
#pragma unroll
        for (int j = 0; j < 4; ++j) { const f32x4 v = xr[64 * j]; s += (v.x * v.x + v.y * v.y) + (v.z * v.z + v.w * v.w);
            o8[64 * j] = (unsigned long long)pk2(v.x, v.y) | ((unsigned long long)pk2(v.z, v.w) << 32); }
        s = wave_sum(s);
        if (lane == 0) rowsq[7 * T_ + m] = s;
    }
    const int gt = gw * 64 + lane, NGT = NGW * 64;
    for (int i = gt; i < 6 * T_; i += NGT) rowsq[T_ + i] = 0.f;
    { const int* pos = (const int*)inp(a, I_POS); float* cs = (float*)(ws + WS_CS);
      for (int i = gt; i < T_ * 16; i += NGT) { const int t = i >> 4, p = i & 15;
          const float inv = exp2f(-(float)p * (13.287712379549449f / 16.f));
          const float ang = (float)pos[t] * inv;
          double rev = (double)ang * 0.15915494309189535; rev -= floor(rev);
          const float rv = (float)rev;
          cs[2 * i] = __builtin_amdgcn_cosf(rv); cs[2 * i + 1] = __builtin_amdgcn_sinf(rv); } }
}
DI void conv8(const bf16* P0, const float* wconv, size_t t, int spos, int ch0, float (&o)[8]) {
#pragma unroll
    for (int i = 0; i < 8; ++i) o[i] = 0.f;
#pragma unroll
    for (int j = 0; j < 4; ++j) {
        const int dt = j - 3;
        if (spos + dt >= 0) {
            const u32x4 raw = *(const u32x4*)(P0 + (size_t)((long)t + dt) * P0W + ch0);
            const f32x4 w0 = *(const f32x4*)(wconv + j * 768 + ch0), w1 = *(const f32x4*)(wconv + j * 768 + ch0 + 4);
            o[0] += w0.x * __uint_as_float(raw.x << 16); o[1] += w0.y * __uint_as_float(raw.x & 0xffff0000u);
            o[2] += w0.z * __uint_as_float(raw.y << 16); o[3] += w0.w * __uint_as_float(raw.y & 0xffff0000u);
            o[4] += w1.x * __uint_as_float(raw.z << 16); o[5] += w1.y * __uint_as_float(raw.z & 0xffff0000u);
            o[6] += w1.z * __uint_as_float(raw.w << 16); o[7] += w1.w * __uint_as_float(raw.w & 0xffff0000u);
        }
    }
#pragma unroll
    for (int i = 0; i < 8; ++i) o[i] = silu(o[i]);
}
constexpr float KSCALE = 0.10206207261596575f;

DI void mlstm_local_unit(const Args& a, LAS unsigned char* lds, int unit, int tid, int lane, int wave) {
    __attribute__((address_space(1))) unsigned char* wsg_ = (__attribute__((address_space(1))) unsigned char*)a.ws; asm volatile("" : "+s"(wsg_)); unsigned char* ws = (unsigned char*)wsg_;
    const int bh = unit >> 5, c = unit & 31, b = bh >> 2, h = bh & 3;
    const size_t t0 = (size_t)b * S_ + (size_t)c * 128;
    const bf16* P0 = (const bf16*)(ws + WS_BIG);
    const float* gates = (const float*)(ws + WS_GATES);
    LAS float* su = (LAS float*)lds;
    LAS bf16* Kt = (LAS bf16*)(lds + 1024);
    LAS bf16* Vt = (LAS bf16*)(lds + 1024 + 96 * 272);
    const int s = tid & 127, gq = tid >> 7;
    LAS bf16* Rw = (LAS bf16*)(lds + 1024 + 96 * 272 + 192 * 272);
    u32x4 rvv[6];
#pragma unroll
    for (int r = 0; r < 6; ++r) rvv[r] = *(const u32x4*)(P0 + (t0 + s) * P0W + 768 + h * 192 + (gq + 4 * r) * 8);
    { u32x4 rr[7];
#pragma unroll
      for (int i = 0; i < 7; ++i) { const int e = min(tid + NTHR * i, 131 * 24 - 1), row = e / 24, cg = e % 24;
          const long tr = (long)t0 - 3 + row; const bool ok_ = (c * 128 - 3 + row) >= 0;
          rr[i] = ok_ ? *(const u32x4*)(P0 + (size_t)(ok_ ? tr : 0) * P0W + (cg < 12 ? h * 96 + cg * 8 : 384 + h * 96 + (cg - 12) * 8)) : (u32x4){0u, 0u, 0u, 0u}; }
#pragma unroll
      for (int i = 0; i < 7; ++i) { const int e = tid + NTHR * i; if (e < 131 * 24) *(LAS u32x4*)(Rw + (e / 24) * 200 + (e % 24) * 8) = rr[i]; } }
    if (wave == 0) {
        const float lf0 = gates[(t0 + 2 * lane) * 8 + 4 + h], lf1 = gates[(t0 + 2 * lane + 1) * 8 + 4 + h];
        const float li0 = gates[(t0 + 2 * lane) * 8 + h], li1 = gates[(t0 + 2 * lane + 1) * 8 + h];
        float p = lf0 + lf1;
#pragma unroll
        for (int o = 1; o < 64; o <<= 1) { const float q = __shfl_up(p, o); if (lane >= o) p += q; }
        const float b1 = p, b0 = p - lf1;
        const float g0 = li0 - b0, g1 = li1 - b1;
        float gm = fmaxf(g0, g1);
#pragma unroll
        for (int o = 1; o < 64; o <<= 1) gm = fmaxf(gm, __shfl_xor(gm, o));
        su[2 * lane] = __expf(g0 - gm); su[2 * lane + 1] = __expf(g1 - gm);
        const float bend = __shfl(b1, 63);
        if (lane == 0) { float* sc = (float*)(ws + WS_SCAL) + 2 * unit; sc[0] = bend; sc[1] = bend + gm; }
    }
    __syncthreads();
    bf16* QKc = (bf16*)(ws + WS_XB) + (t0 + s) * 768 + h * 96;
    const float us = su[s];
    const float* wconv = inp(a, I_WCONV);
#pragma unroll
    for (int r = 0; r < 6; ++r) {
        const int cg = gq + 4 * r, isk = cg >= 12, dg = isk ? cg - 12 : cg, ch0 = (isk ? 384 : 0) + h * 96 + dg * 8;
        float o[8];
#pragma unroll
        for (int i = 0; i < 8; ++i) o[i] = 0.f;
#pragma unroll
        for (int j = 0; j < 4; ++j) {
            const u32x4 raw = *(const LAS u32x4*)(Rw + (s + j) * 200 + cg * 8);
            const f32x4 w0 = *(const f32x4*)(wconv + j * 768 + ch0), w1 = *(const f32x4*)(wconv + j * 768 + ch0 + 4);
            o[0] += w0.x * __uint_as_float(raw.x << 16); o[1] += w0.y * __uint_as_float(raw.x & 0xffff0000u);
            o[2] += w0.z * __uint_as_float(raw.y << 16); o[3] += w0.w * __uint_as_float(raw.y & 0xffff0000u);
            o[4] += w1.x * __uint_as_float(raw.z << 16); o[5] += w1.y * __uint_as_float(raw.z & 0xffff0000u);
            o[6] += w1.z * __uint_as_float(raw.w << 16); o[7] += w1.w * __uint_as_float(raw.w & 0xffff0000u);
        }
        const float ksc = isk ? KSCALE : 1.f;
#pragma unroll
        for (int i = 0; i < 8; ++i) o[i] = silu(o[i]) * ksc;
        u32x4 w; w.x = pk2(o[0], o[1]); w.y = pk2(o[2], o[3]); w.z = pk2(o[4], o[5]); w.w = pk2(o[6], o[7]); *(u32x4*)(QKc + (isk ? 384 : 0) + dg * 8) = w;
        if (isk) {
#pragma unroll
            for (int i = 0; i < 8; ++i) Kt[(dg * 8 + i) * 136 + s] = f2bf(o[i] * us); }
    }
#pragma unroll
    for (int r = 0; r < 6; ++r) {
        const int vg = gq + 4 * r; const u32x4 raw = rvv[r];
        Vt[(vg * 8 + 0) * 136 + s] = (bf16)(raw.x & 0xffff); Vt[(vg * 8 + 1) * 136 + s] = (bf16)(raw.x >> 16);
        Vt[(vg * 8 + 2) * 136 + s] = (bf16)(raw.y & 0xffff); Vt[(vg * 8 + 3) * 136 + s] = (bf16)(raw.y >> 16);
        Vt[(vg * 8 + 4) * 136 + s] = (bf16)(raw.z & 0xffff); Vt[(vg * 8 + 5) * 136 + s] = (bf16)(raw.z >> 16);
        Vt[(vg * 8 + 6) * 136 + s] = (bf16)(raw.w & 0xffff); Vt[(vg * 8 + 7) * 136 + s] = (bf16)(raw.w >> 16);
    }
    __syncthreads();
    float* U = (float*)(ws + WS_BIG + 160 * MiB) + (size_t)unit * (193 * 96);
    if (tid < 384) {
        const int d = tid >> 2, part = tid & 3; float sum = 0.f;
#pragma unroll 8
        for (int i = 0; i < 32; ++i) sum += bf2f(Kt[d * 136 + part * 32 + i]);
        sum += __shfl_xor(sum, 1); sum += __shfl_xor(sum, 2);
        if (part == 0) U[192 * 96 + d] = sum;
    }
    {
        const int dgp = wave & 1, vgp = wave >> 1, r16 = lane & 15, g = lane >> 4;
        f32x4 acc[3][3];
#pragma unroll
        for (int i = 0; i < 3; ++i)
#pragma unroll
            for (int j = 0; j < 3; ++j) acc[i][j] = (f32x4){0.f, 0.f, 0.f, 0.f};
#pragma unroll
        for (int ks = 0; ks < 4; ++ks) {
            bf16x8 af[3], bfr[3];
#pragma unroll
            for (int i = 0; i < 3; ++i) af[i] = *(const LAS bf16x8*)(Kt + ((dgp * 3 + i) * 16 + r16) * 136 + ks * 32 + g * 8);
#pragma unroll
            for (int j = 0; j < 3; ++j) bfr[j] = *(const LAS bf16x8*)(Vt + ((vgp * 3 + j) * 16 + r16) * 136 + ks * 32 + g * 8);
#pragma unroll
            for (int i = 0; i < 3; ++i)
#pragma unroll
                for (int j = 0; j < 3; ++j) acc[i][j] = MFMA16(af[i], bfr[j], acc[i][j]);
        }
#pragma unroll
        for (int i = 0; i < 3; ++i)
#pragma unroll
            for (int j = 0; j < 3; ++j) *(f32x4*)(U + (size_t)((vgp * 3 + j) * 16 + r16) * 96 + (dgp * 3 + i) * 16 + g * 4) = acc[i][j];
    }
    __syncthreads();
}

DI void memattn_unit(const Args& a, LAS unsigned char* lds, const bf16* Qp, int ldq, int qcol0, int unit, int tid, int lane, int wave) {
    __attribute__((address_space(1))) unsigned char* wsg_ = (__attribute__((address_space(1))) unsigned char*)a.ws; asm volatile("" : "+s"(wsg_)); unsigned char* ws = (unsigned char*)wsg_;
    const int rb4 = unit & 7, bh = unit >> 3, b = bh >> 2, h = bh & 3;
    const bf16* MKV = (const bf16*)(ws + WS_MEMKV) + (size_t)b * NMEM * 512;
    LAS bf16* Km = (LAS bf16*)lds;
    LAS bf16* Vt = (LAS bf16*)(lds + 36864);
    LAS bf16* Qs = (LAS bf16*)(lds + 36864 + 33792);
#pragma unroll
    for (int r = 0; r < 4; ++r) { const int gi = tid + NTHR * r, key = gi >> 3, dg = gi & 7;
        *(LAS u32x4*)(Km + key * 72 + dg * 8) = *(const u32x4*)(MKV + (size_t)key * 512 + h * 64 + dg * 8); }
#pragma unroll
    for (int r = 0; r < 4; ++r) { const int gi = tid + NTHR * r, key = gi & 255, vg = gi >> 8;
        const u32x4 raw = *(const u32x4*)(MKV + (size_t)key * 512 + 256 + h * 64 + vg * 8);
        Vt[(vg * 8 + 0) * 264 + key] = (bf16)(raw.x & 0xffff); Vt[(vg * 8 + 1) * 264 + key] = (bf16)(raw.x >> 16);
        Vt[(vg * 8 + 2) * 264 + key] = (bf16)(raw.y & 0xffff); Vt[(vg * 8 + 3) * 264 + key] = (bf16)(raw.y >> 16);
        Vt[(vg * 8 + 4) * 264 + key] = (bf16)(raw.z & 0xffff); Vt[(vg * 8 + 5) * 264 + key] = (bf16)(raw.z >> 16);
        Vt[(vg * 8 + 6) * 264 + key] = (bf16)(raw.w & 0xffff); Vt[(vg * 8 + 7) * 264 + key] = (bf16)(raw.w >> 16); }
#pragma unroll 1
    for (int sb = 0; sb < 4; ++sb) {
    const size_t t0 = (size_t)b * S_ + (size_t)(rb4 * 4 + sb) * 128;
#pragma unroll
    for (int r = 0; r < 2; ++r) { const int gi = tid + NTHR * r, q = gi >> 3, dg = gi & 7;
        *(LAS u32x4*)(Qs + q * 72 + dg * 8) = *(const u32x4*)(Qp + (t0 + q) * ldq + qcol0 + h * 64 + dg * 8); }
    __syncthreads();
    const int r16 = lane & 15, g = lane >> 4, q0 = wave * 16;
    bf16x8 qf[2];
#pragma unroll
    for (int ks = 0; ks < 2; ++ks) qf[ks] = *(const LAS bf16x8*)(Qs + (q0 + r16) * 72 + ks * 32 + g * 8);
    f32x4 sc[16];
#pragma unroll
    for (int kt = 0; kt < 16; ++kt) { sc[kt] = (f32x4){0.f, 0.f, 0.f, 0.f};
#pragma unroll
        for (int ks = 0; ks < 2; ++ks) { const bf16x8 kf = *(const LAS bf16x8*)(Km + (kt * 16 + r16) * 72 + ks * 32 + g * 8); sc[kt] = MFMA16(kf, qf[ks], sc[kt]); } }
    float mx = -INFINITY;
#pragma unroll
    for (int kt = 0; kt < 16; ++kt) mx = fmaxf(mx, fmaxf(fmaxf(sc[kt][0], sc[kt][1]), fmaxf(sc[kt][2], sc[kt][3])));
    mx = fmaxf(mx, __shfl_xor(mx, 16)); mx = xor32_max(mx);
    const float c2 = 0.125f * 1.4426950408889634f; float sum = 0.f;
#pragma unroll
    for (int kt = 0; kt < 16; ++kt)
#pragma unroll
        for (int i = 0; i < 4; ++i) { const float p = __builtin_amdgcn_exp2f((sc[kt][i] - mx) * c2); sc[kt][i] = p; sum += p; }
    sum += __shfl_xor(sum, 16); sum = xor32_sum(sum);
    f32x4 oa[4];
#pragma unroll
    for (int vt = 0; vt < 4; ++vt) oa[vt] = (f32x4){0.f, 0.f, 0.f, 0.f};
#pragma unroll
    for (int k2 = 0; k2 < 8; ++k2) {
        u32x4 pw; pw.x = pk2(sc[2 * k2][0], sc[2 * k2][1]); pw.y = pk2(sc[2 * k2][2], sc[2 * k2][3]); pw.z = pk2(sc[2 * k2 + 1][0], sc[2 * k2 + 1][1]); pw.w = pk2(sc[2 * k2 + 1][2], sc[2 * k2 + 1][3]);
        const bf16x8 pf = __builtin_bit_cast(bf16x8, pw);
#pragma unroll
        for (int vt = 0; vt < 4; ++vt) {
            const s16x4 lo = *(const LAS s16x4*)(Vt + (vt * 16 + r16) * 264 + 32 * k2 + g * 4), hi = *(const LAS s16x4*)(Vt + (vt * 16 + r16) * 264 + 32 * k2 + 16 + g * 4);
            const bf16x8 vf = __builtin_shufflevector(lo, hi, 0, 1, 2, 3, 4, 5, 6, 7);
            oa[vt] = MFMA16(vf, pf, oa[vt]);
        }
    }
    const float inv = 1.f / sum;
    bf16* Y = (bf16*)(ws + WS_Y) + (t0 + q0 + r16) * D_ + 768 + h * 64;
#pragma unroll
    for (int vt = 0; vt < 4; ++vt) { u32x2 w; w.x = pk2(oa[vt][0] * inv, oa[vt][1] * inv); w.y = pk2(oa[vt][2] * inv, oa[vt][3] * inv); *(u32x2*)(Y + vt * 16 + g * 4) = w; }
    __syncthreads();
    }
}

DI void mlstm_scan(const Args& a, int gt, int NGT) {
    __attribute__((address_space(1))) unsigned char* wsg_ = (__attribute__((address_space(1))) unsigned char*)a.ws; asm volatile("" : "+s"(wsg_)); unsigned char* ws = (unsigned char*)wsg_;
    const float* U = (const float*)(ws + WS_BIG + 160 * MiB);
    bf16* Ct = (bf16*)(ws + WS_CT);
    const float* scal = (const float*)(ws + WS_SCAL);
    float* mprev = (float*)(ws + WS_MPREV);
    constexpr int NE = 193 * 96, NE4 = NE / 4;
    for (int idx = gt; idx < 32 * NE4; idx += NGT) {
        const int bh = idx / NE4, e = (idx - bh * NE4) * 4;
        float m = 0.f; f32x4 C = (f32x4){0.f, 0.f, 0.f, 0.f};
        f32x4 u[NCH];
#pragma unroll
        for (int c = 0; c < NCH; ++c) u[c] = *(const f32x4*)(U + (size_t)(bh * NCH + c) * NE + e);
#pragma unroll
        for (int c = 0; c < NCH; ++c) {
            const int unit = bh * NCH + c;
            const float be = scal[2 * unit], ml = scal[2 * unit + 1];
            const float mn = fmaxf(be + m, ml), dec = __expf(be + m - mn), sc = __expf(ml - mn);
            u32x2 w; w.x = pk2(C[0], C[1]); w.y = pk2(C[2], C[3]);
            *(u32x2*)(Ct + (size_t)unit * (CT_ROWS * 96) + e) = w;
            if (e == 0) mprev[unit] = m;
            C = C * dec + u[c] * sc;
            m = mn;
        }
    }
    for (int idx = gt; idx < 1024 * 15 * 96; idx += NGT) { const int unit = idx / (15 * 96), e = idx - unit * (15 * 96); Ct[(size_t)unit * (CT_ROWS * 96) + 193 * 96 + e] = 0; }
}
DI void mlstm_out_phase(const Args& a, LAS unsigned char* lds, int bx, int G, int tid_in) {
    u32x4 rq[2], rkk[3], rvv[6], rct[5]; float rg[4], rmp;
#define MLO_LOADS(u2_) do { const int rh_ = (u2_) & 1, un_ = (u2_) >> 1, bh_ = un_ >> 5, c_ = un_ & 31, b_ = bh_ >> 2, h_ = bh_ & 3; const size_t t0_ = (size_t)b_ * S_ + (size_t)c_ * 128; \
        _Pragma("unroll") for (int i = 0; i < 2; ++i) { const int e = min(tid + NTHR * i, 767); rq[i] = *(const u32x4*)(QKc + (t0_ + rh_ * 64 + e / 12) * 768 + h_ * 96 + (e % 12) * 8); } \
        _Pragma("unroll") for (int i = 0; i < 3; ++i) { const int e = tid + NTHR * i; rkk[i] = *(const u32x4*)(QKc + (t0_ + e / 12) * 768 + 384 + h_ * 96 + (e % 12) * 8); } \
        _Pragma("unroll") for (int r = 0; r < 6; ++r) rvv[r] = *(const u32x4*)(P0 + (t0_ + (tid & 127)) * P0W + 768 + h_ * 192 + ((tid >> 7) + 4 * r) * 8); \
        { const float* gt_ = (const float*)(ws + WS_GATES) + (t0_ + 2 * (tid & 63)) * 8 + h_; rg[0] = gt_[4]; rg[1] = gt_[12]; rg[2] = gt_[0]; rg[3] = gt_[8]; rmp = ((const float*)(ws + WS_MPREV))[un_]; } \
        { const bf16* Ct_ = (const bf16*)(ws + WS_CT) + (size_t)un_ * (CT_ROWS * 96); \
          _Pragma("unroll") for (int i = 0; i < 5; ++i) { const int e = min(tid + NTHR * i, CT_ROWS * 12 - 1); rct[i] = *(const u32x4*)(Ct_ + e * 8); } } } while (0)
    { __attribute__((address_space(1))) unsigned char* wsg0_ = (__attribute__((address_space(1))) unsigned char*)a.ws; asm volatile("" : "+s"(wsg0_)); unsigned char* ws = (unsigned char*)wsg0_;
      const int tid = tid_in; const bf16* P0 = (const bf16*)(ws + WS_BIG); const bf16* QKc = (const bf16*)(ws + WS_XB);
      MLO_LOADS(min(bx, 2047)); }
#pragma unroll 1
    for (int unit2 = bx; unit2 < 2048; unit2 += G) {
    __attribute__((address_space(1))) unsigned char* wsg_ = (__attribute__((address_space(1))) unsigned char*)a.ws; asm volatile("" : "+s"(wsg_)); unsigned char* ws = (unsigned char*)wsg_;
    int tid = tid_in; asm volatile("" : "+v"(tid)); const int lane = tid & 63, wave = tid >> 6;
    const int rh = unit2 & 1, unit = unit2 >> 1, bh = unit >> 5, c = unit & 31, b = bh >> 2, h = bh & 3;
    const size_t t0 = (size_t)b * S_ + (size_t)c * 128;
    const bf16* P0 = (const bf16*)(ws + WS_BIG);
    const bf16* QKc = (const bf16*)(ws + WS_XB);
    LAS float* sM = (LAS float*)lds;
    LAS float* sA = sM + 64;
    LAS float* sE = sM + 128;
    LAS float* sG = sM + 192;
    LAS float* sD = sM + 320;
    LAS float* sQ = sM + 384;
    LAS bf16* A2 = (LAS bf16*)(lds + 4096);
    LAS bf16* B2 = (LAS bf16*)(lds + 4096 + 64 * 464);
    LAS bf16* Ks = B2;
    LAS bf16* Yt = A2;
    const int sv = tid & 127, gq = tid >> 7;
    if (wave == 0) {
        const float lf0 = rg[0], lf1 = rg[1], li0 = rg[2], li1 = rg[3];
        float p = lf0 + lf1;
#pragma unroll
        for (int o = 1; o < 64; o <<= 1) { const float q = __shfl_up(p, o); if (lane >= o) p += q; }
        const float b1 = p, b0 = p - lf1;
        const float g0 = li0 - b0, g1 = li1 - b1;
        float pm = fmaxf(g0, g1);
#pragma unroll
        for (int o = 1; o < 64; o <<= 1) { const float q = __shfl_up(pm, o); if (lane >= o) pm = fmaxf(pm, q); }
        float pmx = __shfl_up(pm, 1); if (lane == 0) pmx = -INFINITY;
        const float pm0 = fmaxf(pmx, g0), pm1 = pm;
        sG[2 * lane] = g0; sG[2 * lane + 1] = g1;
        const float mp = rmp;
        const int jl = 2 * lane - rh * 64;
        if (jl >= 0 && jl < 64) {
            const float M0 = fmaxf(mp, pm0), M1 = fmaxf(mp, pm1);
            sM[jl] = M0; sM[jl + 1] = M1; sA[jl] = __expf(mp - M0); sA[jl + 1] = __expf(mp - M1);
            sE[jl] = __expf(-(b0 + M0)); sE[jl + 1] = __expf(-(b1 + M1));
        }
    }
#pragma unroll
    for (int i = 0; i < 2; ++i) { const int e = tid + NTHR * i; if (e < 768) *(LAS u32x4*)(A2 + (e / 12) * 232 + 128 + (e % 12) * 8) = rq[i]; }
#pragma unroll
    for (int i = 0; i < 3; ++i) { const int e = tid + NTHR * i; *(LAS u32x4*)(Ks + (e / 12) * 104 + (e % 12) * 8) = rkk[i]; }
    __syncthreads();
    const int r16 = lane & 15, g = lane >> 4, rt = wave & 3, wh = wave >> 2;
    {
        f32x4 sacc[4];
#pragma unroll
        for (int j = 0; j < 4; ++j) sacc[j] = (f32x4){0.f, 0.f, 0.f, 0.f};
#pragma unroll
        for (int ks = 0; ks < 3; ++ks) {
            const bf16x8 qf = *(const LAS bf16x8*)(A2 + (rt * 16 + r16) * 232 + 128 + ks * 32 + g * 8);
#pragma unroll
            for (int j = 0; j < 4; ++j) { const bf16x8 kf = *(const LAS bf16x8*)(Ks + ((wh * 4 + j) * 16 + r16) * 104 + ks * 32 + g * 8); sacc[j] = MFMA16(qf, kf, sacc[j]); }
        }
#pragma unroll
        for (int j = 0; j < 4; ++j) { const int s = (wh * 4 + j) * 16 + r16; const float gs = sG[s];
#pragma unroll
            for (int i = 0; i < 4; ++i) { const int jl = rt * 16 + g * 4 + i; const float w = (s <= rh * 64 + jl) ? __expf(gs - sM[jl]) : 0.f; A2[jl * 232 + s] = f2bf(sacc[j][i] * w); } }
    }
    __syncthreads();
    for (int e = tid; e < 64 * 48; e += NTHR) { const int r = e / 48, cp = e % 48; LAS unsigned* p = (LAS unsigned*)(A2 + r * 232 + 128) + cp; const unsigned v = *p; const float s = sA[r];
        *p = pk2(__uint_as_float(v << 16) * s, __uint_as_float(v & 0xffff0000u) * s); }
#pragma unroll
    for (int r = 0; r < 6; ++r) { const int vg = gq + 4 * r; const u32x4 raw = rvv[r];
        B2[(vg * 8 + 0) * 232 + sv] = (bf16)(raw.x & 0xffff); B2[(vg * 8 + 1) * 232 + sv] = (bf16)(raw.x >> 16);
        B2[(vg * 8 + 2) * 232 + sv] = (bf16)(raw.y & 0xffff); B2[(vg * 8 + 3) * 232 + sv] = (bf16)(raw.y >> 16);
        B2[(vg * 8 + 4) * 232 + sv] = (bf16)(raw.z & 0xffff); B2[(vg * 8 + 5) * 232 + sv] = (bf16)(raw.z >> 16);
        B2[(vg * 8 + 6) * 232 + sv] = (bf16)(raw.w & 0xffff); B2[(vg * 8 + 7) * 232 + sv] = (bf16)(raw.w >> 16); }
    for (int e = tid; e < 16 * 128; e += NTHR) { const int r = e >> 7, ss = e & 127; B2[(192 + r) * 232 + ss] = (r == 0) ? (bf16)0x3f80 : (bf16)0; }
#pragma unroll
    for (int i = 0; i < 5; ++i) { const int e = tid + NTHR * i; if (e < CT_ROWS * 12) *(LAS u32x4*)(B2 + (e / 12) * 232 + 128 + (e % 12) * 8) = rct[i]; }
    MLO_LOADS(min(unit2 + G, 2047));
    __syncthreads();
    {
        const int vt0 = wh * 6;
        f32x4 oacc[7];
#pragma unroll
        for (int j = 0; j < 7; ++j) oacc[j] = (f32x4){0.f, 0.f, 0.f, 0.f};
#pragma unroll
        for (int ks = 0; ks < 7; ++ks) {
            const bf16x8 af = *(const LAS bf16x8*)(A2 + (rt * 16 + r16) * 232 + ks * 32 + g * 8);
#pragma unroll
            for (int j = 0; j < 7; ++j) { const bf16x8 bfr = *(const LAS bf16x8*)(B2 + ((vt0 + j) * 16 + r16) * 232 + ks * 32 + g * 8); oacc[j] = MFMA16(af, bfr, oacc[j]); }
        }
        if (wh == 1 && r16 == 0) {
#pragma unroll
            for (int i = 0; i < 4; ++i) sD[rt * 16 + g * 4 + i] = oacc[6][i];
        }
        u32x4 rop[3];
#pragma unroll
        for (int i = 0; i < 3; ++i) { const int e = tid + NTHR * i; rop[i] = *(const u32x4*)(P0 + (t0 + rh * 64 + e / 24) * P0W + 1536 + h * 192 + (e % 24) * 8); }
        __syncthreads();
        float hv[7][4]; float ssq[4] = {0.f, 0.f, 0.f, 0.f};
#pragma unroll
        for (int i = 0; i < 4; ++i) { const int jl = rt * 16 + g * 4 + i; const float dn = __builtin_amdgcn_rcpf(fmaxf(fabsf(sD[jl]), sE[jl]));
#pragma unroll
            for (int j = 0; j < 7; ++j) { const bool valid = (vt0 + j < 12) && !(wh == 1 && j == 0); const float x = valid ? oacc[j][i] * dn : 0.f; hv[j][i] = x; ssq[i] += x * x; } }
#pragma unroll
        for (int i = 0; i < 4; ++i) { float s = ssq[i]; s += __shfl_xor(s, 1); s += __shfl_xor(s, 2); s += __shfl_xor(s, 4); s += __shfl_xor(s, 8); if (r16 == 0) sQ[wh * 64 + rt * 16 + g * 4 + i] = s; }
        __syncthreads();
        const float* whn = inp(a, I_WHNORM) + h * 192;
#pragma unroll
        for (int j = 0; j < 7; ++j) { const int v = (vt0 + j) * 16 + r16; const bool valid = (vt0 + j < 12) && !(wh == 1 && j == 0); const float wv = whn[v < 192 ? v : 0];
#pragma unroll
            for (int i = 0; i < 4; ++i) { const int jl = rt * 16 + g * 4 + i; const float rs = rsqrtf((sQ[jl] + sQ[64 + jl]) * (1.f / 192.f) + RMS_EPS); if (valid) Yt[jl * 200 + v] = f2bf(hv[j][i] * rs * wv); } }
        __syncthreads();
        bf16* Y = (bf16*)(ws + WS_Y);
#pragma unroll
        for (int i = 0; i < 3; ++i) { const int e = tid + NTHR * i, row = e / 24, cg8 = (e % 24) * 8;
            const u32x4 yv = *(const LAS u32x4*)(Yt + row * 200 + cg8); const u32x4 op = rop[i]; u32x4 o;
#define SG2(yw, ow) pk2(__uint_as_float((yw) << 16) * __builtin_amdgcn_rcpf(1.f + __expf(-__uint_as_float((ow) << 16))), __uint_as_float((yw) & 0xffff0000u) * __builtin_amdgcn_rcpf(1.f + __expf(-__uint_as_float((ow) & 0xffff0000u))))
            o.x = SG2(yv.x, op.x); o.y = SG2(yv.y, op.y); o.z = SG2(yv.z, op.z); o.w = SG2(yv.w, op.w);
#undef SG2
            *(u32x4*)(Y + (t0 + rh * 64 + row) * D_ + h * 192 + cg8) = o; }
    }
    __syncthreads();
    }
#undef MLO_LOADS
}

typedef float f32x16 __attribute__((ext_vector_type(16)));
#define MFMA32(a, b, c) __builtin_amdgcn_mfma_f32_32x32x16_bf16((a), (b), (c), 0, 0, 0)
DI int crow32(int i, int hh) { return (i & 3) + 8 * (i >> 2) + 4 * hh; }
DI void mla_unit(const Args& a, LAS unsigned char* lds, int b, int h, int qb, int tid, int lane, int wave) {
    __attribute__((address_space(1))) unsigned char* wsg_ = (__attribute__((address_space(1))) unsigned char*)a.ws; asm volatile("" : "+s"(wsg_)); unsigned char* ws = (unsigned char*)wsg_;
    const bf16* P1 = (const bf16*)(ws + WS_BIG);
    const bf16* Qg = (const bf16*)(ws + WS_BIG + 64 * MiB);
    const bf16* KV = (const bf16*)(ws + WS_BIG + 144 * MiB);
    const size_t tb = (size_t)b * S_;
    const int n32 = lane & 31, hh = lane >> 5;
    const int q0 = qb * 512 + wave * 64;
    bf16x8 qf[2][6];
#pragma unroll
    for (int qs = 0; qs < 2; ++qs)
#pragma unroll
        for (int ks = 0; ks < 6; ++ks) qf[qs][ks] = *(const bf16x8*)(Qg + (tb + q0 + qs * 32 + n32) * QW + h * 96 + ks * 16 + hh * 8);
    f32x16 oa[2][2];
#pragma unroll
    for (int vt = 0; vt < 2; ++vt)
#pragma unroll
        for (int qs = 0; qs < 2; ++qs)
#pragma unroll
            for (int i = 0; i < 16; ++i) oa[vt][qs][i] = 0.f;
    float mrun[2] = {-INFINITY, -INFINITY}, lsum[2] = {0.f, 0.f};
    const int ntile = 4 * (qb + 1), wdiag = 8 * qb + wave;
    const int k0key = tid / 12, k0dg = tid % 12, k1key = min((tid + 512) / 12, 63), k1dg = (tid + 512) % 12;
    u32x4 rk0, rk1, rv;
#define MLA_LOAD(kt_, hf_) do { const size_t tk = tb + (size_t)(kt_) * 128 + (hf_) * 64; \
        rk0 = (k0dg < 8) ? *(const u32x4*)(KV + (tk + k0key) * KVW + h * 128 + k0dg * 8) : *(const u32x4*)(P1 + (tk + k0key) * P1W + 640 + (k0dg - 8) * 8); \
        rk1 = (k1dg < 8) ? *(const u32x4*)(KV + (tk + k1key) * KVW + h * 128 + k1dg * 8) : *(const u32x4*)(P1 + (tk + k1key) * P1W + 640 + (k1dg - 8) * 8); \
        rv = *(const u32x4*)(KV + (tk + lane) * KVW + h * 128 + 64 + wave * 8); } while (0)
#define MLA_STORE(buf_, hf_) do { LAS bf16* Kl = (LAS bf16*)(lds + (buf_) * 45568) + (hf_) * 64 * 104; LAS bf16* Vl = (LAS bf16*)(lds + (buf_) * 45568 + 26624) + (hf_) * 64; \
        *(LAS u32x4*)(Kl + k0key * 104 + k0dg * 8) = rk0; if (tid < 256) *(LAS u32x4*)(Kl + k1key * 104 + k1dg * 8) = rk1; \
        Vl[(wave * 8 + 0) * 136 + lane] = (bf16)(rv.x & 0xffff); Vl[(wave * 8 + 1) * 136 + lane] = (bf16)(rv.x >> 16); Vl[(wave * 8 + 2) * 136 + lane] = (bf16)(rv.y & 0xffff); Vl[(wave * 8 + 3) * 136 + lane] = (bf16)(rv.y >> 16); \
        Vl[(wave * 8 + 4) * 136 + lane] = (bf16)(rv.z & 0xffff); Vl[(wave * 8 + 5) * 136 + lane] = (bf16)(rv.z >> 16); Vl[(wave * 8 + 6) * 136 + lane] = (bf16)(rv.w & 0xffff); Vl[(wave * 8 + 7) * 136 + lane] = (bf16)(rv.w >> 16); } while (0)
    MLA_LOAD(0, 0); MLA_STORE(0, 0); MLA_LOAD(0, 1); MLA_STORE(0, 1);
    __syncthreads();
#pragma unroll 1
    for (int kt = 0; kt < ntile; ++kt) {
        const int buf = kt & 1;
        const bool more = kt + 1 < ntile;
        if (more) MLA_LOAD(kt + 1, 0);
        const LAS bf16* Kl = (const LAS bf16*)(lds + buf * 45568); const LAS bf16* Vl = (const LAS bf16*)(lds + buf * 45568 + 26624);
#pragma unroll
        for (int hf = 0; hf < 2; ++hf) {
#pragma unroll 1
            for (int ksub = 2 * hf; ksub < 2 * hf + 2 && 4 * kt + ksub <= 2 * wdiag + 1; ++ksub) {
                f32x16 sc[2];
#pragma unroll
                for (int qs = 0; qs < 2; ++qs)
#pragma unroll
                    for (int i = 0; i < 16; ++i) sc[qs][i] = 0.f;
                bf16x8 kf[6];
#pragma unroll
                for (int ks = 0; ks < 6; ++ks) kf[ks] = *(const LAS bf16x8*)(Kl + (ksub * 32 + n32) * 104 + ks * 16 + hh * 8);
                __builtin_amdgcn_sched_barrier(0);
                __builtin_amdgcn_s_setprio(1);
#pragma unroll
                for (int ks = 0; ks < 6; ++ks) { sc[0] = MFMA32(kf[ks], qf[0][ks], sc[0]); sc[1] = MFMA32(kf[ks], qf[1][ks], sc[1]); }
                __builtin_amdgcn_s_setprio(0);
                s16x4 vlo[2][2], vhi[2][2];
#pragma unroll
                for (int s2 = 0; s2 < 2; ++s2)
#pragma unroll
                    for (int vt = 0; vt < 2; ++vt) { const LAS bf16* vp = Vl + (vt * 32 + n32) * 136 + ksub * 32 + 16 * s2 + 4 * hh; vlo[s2][vt] = *(const LAS s16x4*)vp; vhi[s2][vt] = *(const LAS s16x4*)(vp + 8); }
                if (4 * kt + ksub >= 2 * wdiag) { const int koff = (4 * kt + ksub - 2 * wdiag) * 32;
#pragma unroll
                    for (int qs = 0; qs < 2; ++qs)
#pragma unroll
                        for (int i = 0; i < 16; ++i) if (koff + crow32(i, hh) > qs * 32 + n32) sc[qs][i] = -INFINITY;
                }
#pragma unroll
                for (int qs = 0; qs < 2; ++qs) {
                    float tm = sc[qs][0];
#pragma unroll
                    for (int i = 1; i < 16; ++i) tm = fmaxf(tm, sc[qs][i]);
                    tm = xor32_max(tm);
                    const float mold = mrun[qs], mnew = fmaxf(mold, tm);
                    mrun[qs] = mnew; f32x2 ps2 = {0.f, 0.f}; const f32x2 mn2 = {mnew, mnew};
#pragma unroll
                    for (int i = 0; i < 8; ++i) { f32x2 d = {sc[qs][2 * i], sc[qs][2 * i + 1]}; d = d - mn2;
                        f32x2 p; p.x = __builtin_amdgcn_exp2f(d.x); p.y = __builtin_amdgcn_exp2f(d.y); sc[qs][2 * i] = p.x; sc[qs][2 * i + 1] = p.y; ps2 = ps2 + p; }
                    const float ps = ps2.x + ps2.y;
                    if (__builtin_amdgcn_ballot_w64(mnew > mold) != 0ull) {
                        const float alpha = __builtin_amdgcn_exp2f(mold - mnew);
                        lsum[qs] *= alpha;
#pragma unroll
                        for (int vt = 0; vt < 2; ++vt) oa[vt][qs] = oa[vt][qs] * alpha;
                    }
                    lsum[qs] += ps;
                }
#pragma unroll
                for (int s2 = 0; s2 < 2; ++s2) {
                    bf16x8 pf[2];
#pragma unroll
                    for (int qs = 0; qs < 2; ++qs) { u32x4 pw; pw.x = pk2(sc[qs][8 * s2 + 0], sc[qs][8 * s2 + 1]); pw.y = pk2(sc[qs][8 * s2 + 2], sc[qs][8 * s2 + 3]);
                        pw.z = pk2(sc[qs][8 * s2 + 4], sc[qs][8 * s2 + 5]); pw.w = pk2(sc[qs][8 * s2 + 6], sc[qs][8 * s2 + 7]); pf[qs] = __builtin_bit_cast(bf16x8, pw); }
#pragma unroll
                    for (int vt = 0; vt < 2; ++vt) {
                        const bf16x8 vf = __builtin_shufflevector(vlo[s2][vt], vhi[s2][vt], 0, 1, 2, 3, 4, 5, 6, 7);
                        oa[vt][0] = MFMA32(vf, pf[0], oa[vt][0]); oa[vt][1] = MFMA32(vf, pf[1], oa[vt][1]);
                    }
                }
            }
            if (more) { MLA_STORE(buf ^ 1, hf); if (hf == 0) MLA_LOAD(kt + 1, 1); }
        }
        __syncthreads();
    }
#undef MLA_LOAD
#undef MLA_STORE
#pragma unroll
    for (int qs = 0; qs < 2; ++qs) {
        float l = xor32_sum(lsum[qs]);
        const float inv = 1.f / l;
        bf16* Y = (bf16*)(ws + WS_Y) + (tb + q0 + qs * 32 + n32) * D_ + h * 64;
#pragma unroll
        for (int vt = 0; vt < 2; ++vt)
#pragma unroll
            for (int g4 = 0; g4 < 4; ++g4) { u32x2 w; w.x = pk2(oa[vt][qs][4 * g4] * inv, oa[vt][qs][4 * g4 + 1] * inv); w.y = pk2(oa[vt][qs][4 * g4 + 2] * inv, oa[vt][qs][4 * g4 + 3] * inv);
                *(u32x2*)(Y + vt * 32 + 8 * g4 + 4 * hh) = w; }
    }
}
#define XB_TMO      128
#define XB_XCNT(j)  (256  + 64 * (j))
#define XB_XSUB(j)  (1280 + 64 * (j))
#define XB_XGEN(j)  (2304 + 64 * (j))
#define XB_TOP      3328
#define XB_TOPGEN   3392
#define XCD_BAR_WORDS 3456
#define XB_SPIN_CAP (1u << 18)

__device__ __forceinline__ unsigned xb_ld(unsigned* p)              { return __hip_atomic_load(p, __ATOMIC_RELAXED, __HIP_MEMORY_SCOPE_AGENT); }
__device__ __forceinline__ unsigned xb_add(unsigned* p, unsigned v) { return __hip_atomic_fetch_add(p, v, __ATOMIC_RELAXED, __HIP_MEMORY_SCOPE_AGENT); }
__device__ __forceinline__ unsigned xb_xcc_id() { return (unsigned)__builtin_amdgcn_s_getreg((3 << 11) | 20) & 0xFu; }
#define XB_SPIN(cond, bar) do { unsigned _sp = 0; while (cond) { __builtin_amdgcn_s_sleep(1); \
    if ((++_sp & 255u) == 0u) { if (xb_ld(&(bar)[XB_TMO])) break; if (_sp > XB_SPIN_CAP) { atomicAdd(&(bar)[XB_TMO], 1u); break; } } } } while (0)

struct XcdBarrier {
    unsigned* bar; unsigned x;
    volatile LAS unsigned* st;
};

__device__ __forceinline__ XcdBarrier xcd_barrier_post(unsigned* bar, volatile LAS unsigned* st) {
    XcdBarrier b; b.bar = bar; b.x = xb_xcc_id(); b.st = st;
    if (threadIdx.x == 0) (void)xb_add(&bar[XB_XCNT(b.x)], 1u);
    return b;
}
__device__ __forceinline__ void xcd_barrier_complete(unsigned* bar, unsigned x, unsigned& nloc, unsigned& nx) {
    const unsigned G = gridDim.x * gridDim.y * gridDim.z;
    unsigned sum, cnt, mine, sp = 0u;
    for (;;) {
        sum = 0u; cnt = 0u; mine = 0u;
#pragma unroll
        for (unsigned j = 0; j < 16; ++j) { const unsigned c = xb_ld(&bar[XB_XCNT(j)]); sum += c; cnt += (c > 0u) ? 1u : 0u; mine = (j == x) ? c : mine; }
        if (sum == G) break;
        __builtin_amdgcn_s_sleep(1);
        if ((++sp & 255u) == 0u) { if (xb_ld(&bar[XB_TMO])) break; if (sp > XB_SPIN_CAP) { atomicAdd(&bar[XB_TMO], 1u); break; } }
    }
    nloc = mine > 0u ? mine : 1u; nx = cnt > 0u ? cnt : 1u;
}

__device__ __forceinline__ void xcd_barrier(const XcdBarrier& b) {
    asm volatile("s_waitcnt vmcnt(0)" ::: "memory");
    __syncthreads();
    if (threadIdx.x == 0) {
        unsigned* bar = b.bar;
        __builtin_amdgcn_s_waitcnt(0);
        unsigned nloc = b.st[0], nx = b.st[1];
        if (nloc == 0u) { xcd_barrier_complete(bar, b.x, nloc, nx); b.st[0] = nloc; b.st[1] = nx; }
        const unsigned old = xb_add(&bar[XB_XSUB(b.x)], 1u);
        const unsigned gen = old / nloc;
        if (old + 1u == (gen + 1u) * nloc) {
            __builtin_amdgcn_fence(__ATOMIC_RELEASE, "agent");
            asm volatile("s_waitcnt vmcnt(0)" ::: "memory");
            const unsigned og = xb_add(&bar[XB_TOP], 1u);
            const unsigned tg = og / nx;
            if (og + 1u == (tg + 1u) * nx) xb_add(&bar[XB_TOPGEN], 1u);
            else XB_SPIN(xb_ld(&bar[XB_TOPGEN]) == tg, bar);
            __builtin_amdgcn_fence(__ATOMIC_ACQUIRE, "agent");
            xb_add(&bar[XB_XGEN(b.x)], 1u);
            asm volatile("s_waitcnt vmcnt(0)" ::: "memory");
        } else {
            XB_SPIN(xb_ld(&bar[XB_XGEN(b.x)]) == gen, bar);
            __builtin_amdgcn_fence(__ATOMIC_ACQUIRE, "agent");
            asm volatile("s_waitcnt vmcnt(0)" ::: "memory");
        }
    }
    __syncthreads();
}

constexpr size_t WS_BAR = 7 * 131072 + 65536;
constexpr int LDS_BARST = LDS_BYTES - 64;
constexpr int NPHASE = 15;
static_assert(pg8::EP_CS == WS_CS && pg8::EP_MEMKV == WS_MEMKV && pg8::EP_XB == WS_XB && pg8::EP_BIG == WS_BIG && pg8::EP_T == T_ && WS_ROWSQ == 0, "epilogue constants");
__global__ void __launch_bounds__(NTHR, 2) fwd_mega(Args a) {
    extern __shared__ __attribute__((aligned(16))) unsigned char lds_raw[];
    LAS unsigned char* lds = (LAS unsigned char*)lds_raw;
    cg::grid_group grid = cg::this_grid();
    const int G = gridDim.x, bx = blockIdx.x;
#define TIDS int tid = threadIdx.x; asm volatile("" : "+v"(tid)); const int lane = tid & 63, wave = __builtin_amdgcn_readfirstlane(tid >> 6); int G_ = G; asm volatile("" : "+s"(G_)); const int gw = bx * NWAVES + wave, gt = bx * NTHR + tid, NGW = G_ * NWAVES, NGT = G_ * NTHR; (void)gw; (void)gt; (void)lane; (void)NGW; (void)NGT;
    for (int ph = a.ph_lo; ph < a.ph_hi; ++ph) {
        __attribute__((address_space(1))) unsigned char* wsg_ = (__attribute__((address_space(1))) unsigned char*)a.ws; asm volatile("" : "+s"(wsg_)); unsigned char* ws = (unsigned char*)wsg_;
        float* rowsq = (float*)(ws + WS_ROWSQ); (void)rowsq;
        bf16* XB = (bf16*)(ws + WS_XB); bf16* Yb = (bf16*)(ws + WS_Y); bf16* Hb = (bf16*)(ws + WS_BIG);
        bf16* P0 = (bf16*)(ws + WS_BIG); bf16* P1 = (bf16*)(ws + WS_BIG); bf16* Qb = (bf16*)(ws + WS_BIG + 64 * MiB); bf16* KVb = (bf16*)(ws + WS_BIG + 144 * MiB);
        const float* cs = (const float*)(ws + WS_CS);
        {
        int j0 = 0, j1 = 0;
        if (ph == 1) { j0 = 0; j1 = 2; } else if (ph == 5) { j0 = 2; j1 = 3; } else if (ph == 6) { j0 = 3; j1 = 4; } else if (ph == 7) { j0 = 4; j1 = 5; } else if (ph == 8) { j0 = 5; j1 = 6; }
        else if (ph == 9) { j0 = 6; j1 = 8; } else if (ph == 11) { j0 = 8; j1 = 9; } else if (ph == 12) { j0 = 9; j1 = 10; } else if (ph == 13) { j0 = 10; j1 = 11; }
        for (int job = j0; job < j1; ++job) {
            pg8::Gemm g; pg8::Epi e{job, ws, a};
            g.M = T_; g.lda = 1024; g.K = 1024; g.N = 1024; g.A = XB; g.Bt = nullptr;
            switch (job) {
                case 0: g.Bt = (const bf16*)(ws + WS_WIN0); g.N = P0W; break;
                case 1: g.A = (const bf16*)(ws + WS_MEMBF); g.Bt = (const bf16*)(ws + WS_WMEM); g.M = TM_; g.N = 512; break;
                case 2: g.A = Yb; g.Bt = (const bf16*)(ws + WS_WOUT0); break;
                case 3: g.Bt = (const bf16*)(ws + WS_WFF1_0); g.N = FF_; break;
                case 4: g.A = Hb; g.lda = FF_; g.K = FF_; g.Bt = (const bf16*)(ws + WS_WFF2_0); break;
                case 5: g.Bt = (const bf16*)(ws + WS_WIN1); break;
                case 6: g.A = P1 + 256; g.K = 384; g.Bt = (const bf16*)(ws + WS_WUQ); g.N = QW; break;
                case 7: g.A = P1; g.K = 256; g.Bt = (const bf16*)(ws + WS_WUKV); g.N = KVW; break;
                case 8: g.A = Yb; g.Bt = (const bf16*)(ws + WS_WOUT1); break;
                case 9: g.Bt = (const bf16*)(ws + WS_WFF1_1); g.N = FF_; break;
                default: g.A = Hb; g.lda = FF_; g.K = FF_; g.Bt = (const bf16*)(ws + WS_WFF2_1); break;
            }
            pg8::StaticOrder S; S.init(g.M, g.N, G, bx);
            pg8::gemm_phase<pg8::Epi, pg8::StaticOrder, true, true>(lds, g, S, e);
            __syncthreads();
        }
        if (ph == 0) { TIDS; p0_prologue(a, lds, gw, NGW, lane, wave, tid); }
        else if (ph == 2) { TIDS;
            for (int u = bx; u < 1024; u += G) mlstm_local_unit(a, lds, u, tid, lane, wave);
            for (int u = bx; u < 256; u += G) memattn_unit(a, lds, P0, P0W, 2304, u, tid, lane, wave);
        }
        else if (ph == 3) { TIDS; mlstm_scan(a, gt, NGT); }
        else if (ph == 4) { TIDS; mlstm_out_phase(a, lds, bx, G, tid); }
        else if (ph == 10) { TIDS;
            for (int r = 0; r * G < 768; ++r) { const int i = (G == 256 && r == 1) ? 511 - bx : r * G + bx; if (i < 768) { const int qb = 7 - i / 96, bh = i % 96; mla_unit(a, lds, bh / 12, bh % 12, qb, tid, lane, wave); } }
            for (int u = bx; u < 256; u += G) memattn_unit(a, lds, P1, P1W, 768, u, tid, lane, wave);
        }
        else if (ph == 14) { TIDS;
            const float* fg = inp(a, I_FINALNORM);
            for (int m0 = gw; m0 < T_; m0 += 4 * NGW) {
                f32x4 xv[4][4]; float rs[4];
                const f32x4 gv0 = ((const f32x4*)fg)[lane], gv1 = ((const f32x4*)fg)[64 + lane], gv2 = ((const f32x4*)fg)[128 + lane], gv3 = ((const f32x4*)fg)[192 + lane];
#pragma unroll
                for (int rr = 0; rr < 4; ++rr) { const int m = min(m0 + rr * NGW, T_ - 1); const f32x4* xr = (const f32x4*)(a.out + (size_t)m * D_) + lane; rs[rr] = rsqrtf(rowsq[4 * T_ + m] * (1.f / D_) + RMS_EPS);
#pragma unroll
                    for (int j = 0; j < 4; ++j) xv[rr][j] = xr[64 * j]; }
#pragma unroll
                for (int rr = 0; rr < 4; ++rr) { const int m = m0 + rr * NGW; if (m < T_) { f32x4* xw = (f32x4*)(a.out + (size_t)m * D_) + lane;
                        xw[0] = xv[rr][0] * rs[rr] * gv0; xw[64] = xv[rr][1] * rs[rr] * gv1; xw[128] = xv[rr][2] * rs[rr] * gv2; xw[192] = xv[rr][3] * rs[rr] * gv3; } }
            }
        }
        }
        if (ph + 1 < a.ph_hi) {
            if (a.ph_hi < 0) grid.sync();
            if (ph == a.ph_lo && threadIdx.x == 0) {
                volatile LAS unsigned* st_ = (volatile LAS unsigned*)(lds + LDS_BARST); st_[0] = 0u; st_[1] = 0u; (void)xb_add((unsigned*)(a.ws + WS_BAR) + XB_XCNT(xb_xcc_id()), 1u); }
            { XcdBarrier xb_; xb_.bar = (unsigned*)(a.ws + WS_BAR); xb_.x = xb_xcc_id(); xb_.st = (volatile LAS unsigned*)(lds + LDS_BARST); xcd_barrier(xb_); }
        }
    }
}

extern "C" void kernel_launch(void* const* d_in, const int* in_sizes, int n_in, void* d_out, int out_size, void* d_ws, size_t ws_size, hipStream_t stream) {
    static int grid = 0;
    if (grid == 0) {
        if (n_in != 26 || ws_size < WS_END || out_size != T_ * D_) { fprintf(stderr, "kernel_launch: unexpected problem (n_in %d, ws %zu, out %d)\n", n_in, ws_size, out_size); grid = -1; return; }
        int dev = 0, cus = 0, per_cu = 0;
        (void)hipGetDevice(&dev); (void)hipDeviceGetAttribute(&cus, hipDeviceAttributeMultiprocessorCount, dev);
        if (hipFuncSetAttribute((const void*)fwd_mega, hipFuncAttributeMaxDynamicSharedMemorySize, LDS_BYTES) != hipSuccess) { fprintf(stderr, "kernel_launch: hipFuncSetAttribute failed\n"); grid = -1; return; }
        if (hipOccupancyMaxActiveBlocksPerMultiprocessor(&per_cu, (const void*)fwd_mega, NTHR, LDS_BYTES) != hipSuccess || per_cu < 1) { fprintf(stderr, "kernel_launch: occupancy query gave %d\n", per_cu); per_cu = 1; }
        (void)hipGetLastError();
        grid = cus * per_cu;
        fprintf(stderr, "kernel_launch: grid %d (cus %d x %d)\n", grid, cus, per_cu);
    }
    if (grid < 0) return;
    if (!MK_MULTI) (void)hipMemsetAsync((unsigned char*)d_ws + WS_BAR, 0, 16384, stream);
    Args a{};
    for (int i = 0; i < 26; ++i) a.in[i] = (const float*)d_in[i];
    a.out = (float*)d_out; a.ws = (unsigned char*)d_ws;
#if MK_MULTI
    for (int ph = 0; ph < NPHASE; ++ph) { a.ph_lo = ph; a.ph_hi = ph + 1; hipLaunchKernelGGL(fwd_mega, dim3(grid), dim3(NTHR), LDS_BYTES, stream, a); }
#else
    a.ph_lo = 0; a.ph_hi = NPHASE;
    void* args[] = {&a};
    hipError_t e = hipLaunchCooperativeKernel((const void*)fwd_mega, dim3(grid), dim3(NTHR), args, LDS_BYTES, stream);
    if (e != hipSuccess) fprintf(stderr, "kernel_launch: cooperative launch failed: %s (grid %d)\n", hipGetErrorString(e), grid);
#endif
}
```

```cpp
#include <hip/hip_runtime.h>
#include <hip/hip_cooperative_groups.h>
#include <cstdio>
#include <cstdint>
namespace cg = cooperative_groups;
constexpr float RMS_EPS = 1e-6f;
#ifndef MK_MULTI
#define MK_MULTI 0
#endif
#ifndef PROBE_MASK
#define PROBE_MASK 0
#endif
struct KArgs { const float* in[26]; float* out; unsigned char* ws; int ph_lo, ph_hi; };
namespace pg8 {
#define PG8_LAS __attribute__((address_space(3)))
typedef unsigned short bf16_t;
typedef short bf16x8 __attribute__((ext_vector_type(8)));
typedef float f32x4 __attribute__((ext_vector_type(4)));
typedef unsigned u32x4 __attribute__((ext_vector_type(4)));
constexpr int BM = 256, BK = 64, HALF = 128, HTB = HALF * BK * 2  , STAGE_BYTES = 8 * HTB, NXCD = 8, WGM = 8;

__host__ __device__ __forceinline__ int lds_byte(int r, int c) { const int st = (r >> 4) * 2 + (c >> 5), rr = r & 15, cc = c & 31, ob = rr * 64 + cc * 2; return st * 1024 + (ob ^ (((ob >> 9) & 1) << 5)); }
__host__ __device__ __forceinline__ void stage_rc(int b, int& R, int& C) { const int st = b / 1024, sb = b % 1024, swz = sb ^ (((sb >> 9) & 1) << 5); R = (st >> 1) * 16 + swz / 64; C = (st & 1) * 32 + (swz % 64) / 2; }
__host__ __device__ __forceinline__ int perm32(int rho) { const int n = rho >> 4, i = rho & 15; return 8 * (i >> 2) + 4 * n + (i & 3); }

struct Unit { int pm, pn; };
struct Gemm { const bf16_t* A; const bf16_t* Bt; int M, N, K, lda; };

struct StaticOrder {
    int nM, nN, nwg, G, c, inv;
    __host__ __device__ void init(int M, int N, int G_, int c_) { nM = M / BM; nN = N / BM; nwg = nM * nN; G = G_; c = c_; inv = ((1 << 20) + WGM * nN - 1) / (WGM * nN); }
    __host__ __device__ bool next(int i, Unit& u) const {
        const long L = (long)i * G + c; if (L >= nwg) return false;
        int wgid = (int)L; { const int q = nwg / NXCD, r = nwg % NXCD, xcd = wgid % NXCD, off = wgid / NXCD; wgid = (xcd < r ? xcd * (q + 1) : r * (q + 1) + (xcd - r) * q) + off; }
        const int nig = WGM * nN, gid = (int)(((unsigned)wgid * (unsigned)inv) >> 20), rem = wgid - gid * nig, fm = gid * WGM, gsz = (nM - fm) < WGM ? (nM - fm) : WGM;
        if (gsz == WGM) { u.pm = fm + (rem & (WGM - 1)); u.pn = rem >> 3; }
        else { u.pm = fm + (rem % gsz); u.pn = rem / gsz; }
        return true;
    }
    __device__ __forceinline__ void a_ready(const Unit&) const {}
    __device__ __forceinline__ void done(const Unit&) const {}
};

__device__ __forceinline__ unsigned cvt_pk_bf16(float lo, float hi) { unsigned r; asm volatile("v_cvt_pk_bf16_f32 %0, %1, %2" : "=v"(r) : "v"(lo), "v"(hi)); return r; }

constexpr size_t EP_CS = 2u << 20, EP_MEMKV = 8u << 20, EP_XB = 64u << 20, EP_BIG = 232u << 20; constexpr int EP_T = 32768;
struct Epi {
    static constexpr bool PERM = true, AFTER_DRAIN = false;
    int job; unsigned char* ws; const KArgs& ka;
    template <int MODE> __device__ __forceinline__ void body(const f32x4 (&acc)[2][2][4][2], const Unit& u, int wr, int wc, int fr, int fq,
            int ldc, bf16_t* O, const float* rowsq, float inv_n, float oscale, float* sqA, float* sqB, const float* cs, const float* xold, float* xnew) const {
        const int row0 = u.pm * BM + wr * 64 + fr, col0 = u.pn * BM + wc * 32 + 8 * fq;
        float rsv[8];
#pragma unroll
        for (int r8 = 0; r8 < 8; ++r8) rsv[r8] = (MODE != 3) ? rowsq[row0 + (r8 >> 2) * HALF + (r8 & 3) * 16] : 0.f;
        f32x4 xn[2][2];
        if (MODE == 3) {
#pragma unroll
            for (int bj = 0; bj < 2; ++bj) { const float* xp = xold + (size_t)row0 * ldc + col0 + bj * HALF; xn[bj][0] = *(const f32x4*)xp; xn[bj][1] = *(const f32x4*)(xp + 4); }
        }
#pragma unroll
        for (int ai = 0; ai < 2; ++ai)
#pragma unroll
            for (int m = 0; m < 4; ++m) {
                const int row = row0 + ai * HALF + m * 16;
                float rs = 1.f;
                if (MODE != 3) rs = rsqrtf(rsv[ai * 4 + m] * inv_n + RMS_EPS) * oscale;
                f32x4 xc[2][2];
                if (MODE == 3) {
#pragma unroll
                    for (int bj = 0; bj < 2; ++bj) { xc[bj][0] = xn[bj][0]; xc[bj][1] = xn[bj][1]; }
                    if (ai * 4 + m < 7) { const int rown = row0 + ((ai * 4 + m + 1) >> 2) * HALF + ((ai * 4 + m + 1) & 3) * 16;
#pragma unroll
                        for (int bj = 0; bj < 2; ++bj) { const float* xp = xold + (size_t)rown * ldc + col0 + bj * HALF; xn[bj][0] = *(const f32x4*)xp; xn[bj][1] = *(const f32x4*)(xp + 4); } }
                }
                float ss[2];
#pragma unroll
                for (int bj = 0; bj < 2; ++bj) {
                    const int col = col0 + bj * HALF;
                    f32x4 v0 = acc[ai][bj][m][0] * rs, v1 = acc[ai][bj][m][1] * rs;
                    if (MODE == 3) {
                        v0 = v0 + xc[bj][0]; v1 = v1 + xc[bj][1];
                        *(f32x4*)(xnew + (size_t)row * ldc + col) = v0; *(f32x4*)(xnew + (size_t)row * ldc + col + 4) = v1;
                    }
                    if (MODE == 4) {
#pragma unroll
                        for (int e = 0; e < 4; ++e) { const float a = fmaxf(v0[e], 0.f), b = fmaxf(v1[e], 0.f); v0[e] = a * a; v1[e] = b * b; }
                    }
                    ss[bj] = (v0[0] * v0[0] + v0[1] * v0[1]) + (v0[2] * v0[2] + v0[3] * v0[3]) + (v1[0] * v1[0] + v1[1] * v1[1]) + (v1[2] * v1[2] + v1[3] * v1[3]);
                    bool rope = false; int p = 0;
                    if (MODE == 1) { rope = (u.pn == 2 && bj == 1 && wc == 0); p = 4 * fq; }
                    if (MODE == 2) { const int j = col % 96; rope = (j >= 64) && (col < 1152); p = (j - 64) >> 1; }
                    if (rope) {
                        const f32x4 c0 = *(const f32x4*)(cs + (size_t)row * 32 + 2 * p), c1 = *(const f32x4*)(cs + (size_t)row * 32 + 2 * p + 4);
                        f32x4 r0, r1;
                        r0[0] = v0[0] * c0[0] - v0[1] * c0[1]; r0[1] = v0[1] * c0[0] + v0[0] * c0[1];
                        r0[2] = v0[2] * c0[2] - v0[3] * c0[3]; r0[3] = v0[3] * c0[2] + v0[2] * c0[3];
                        r1[0] = v1[0] * c1[0] - v1[1] * c1[1]; r1[1] = v1[1] * c1[0] + v1[0] * c1[1];
                        r1[2] = v1[2] * c1[2] - v1[3] * c1[3]; r1[3] = v1[3] * c1[2] + v1[2] * c1[3];
                        v0 = r0; v1 = r1;
                    }
                    u32x4 w; w.x = cvt_pk_bf16(v0[0], v0[1]); w.y = cvt_pk_bf16(v0[2], v0[3]); w.z = cvt_pk_bf16(v1[0], v1[1]); w.w = cvt_pk_bf16(v1[2], v1[3]);
                    if (job != 10) *(u32x4*)(O + (size_t)row * ldc + col) = w;
                }
                if (MODE == 1 || MODE == 3) {
                    float s0 = ss[0], s1 = ss[1];
                    s0 += __shfl_xor(s0, 16); s0 += __shfl_xor(s0, 32); s1 += __shfl_xor(s1, 16); s1 += __shfl_xor(s1, 32);
                    if (fq == 0) {
                        if (MODE == 3) unsafeAtomicAdd(sqA + row, s0 + s1);
                        else { if (u.pn == 0) unsafeAtomicAdd(sqA + row, s0 + s1); else if (u.pn == 1) unsafeAtomicAdd(sqB + row, s0 + s1); else if (u.pn == 2) unsafeAtomicAdd(sqB + row, s0); }
                    }
                }
            }
    }
    __device__ __forceinline__ void operator()(const f32x4 (&acc)[2][2][4][2], const Unit& u, int wr, int wc, int fr, int fq) const {
        float* rsq = (float*)ws; const float* cs = (const float*)(ws + EP_CS); float* xo = ka.out;
        bf16_t* OB = (bf16_t*)(ws + EP_BIG); bf16_t* OX = (bf16_t*)(ws + EP_XB);
        const float kq = 0.10206207261596575f * 1.4426950408889634f;
#define EPI_CALL(MODE_, LDC_, O_, RSQ_, INVN_, OSC_, SQA_, SQB_, XOLD_) body<MODE_>(acc, u, wr, wc, fr, fq, LDC_, O_, RSQ_, INVN_, OSC_, SQA_, SQB_, cs, XOLD_, xo)
        switch (job) {
            case 0: EPI_CALL(0, 2560, OB, rsq, 1.f / 1024.f, 1.f, nullptr, nullptr, xo); break;
            case 1: EPI_CALL(0, 512, (bf16_t*)(ws + EP_MEMKV), rsq + 7 * EP_T, 1.f / 1024.f, 1.f, nullptr, nullptr, xo); break;
            case 2: EPI_CALL(3, 1024, OX, rsq, 1.f / 1024.f, 1.f, rsq + 1 * EP_T, nullptr, ka.in[0]); break;
            case 3: EPI_CALL(4, 4096, OB, rsq + 1 * EP_T, 1.f / 1024.f, 1.f, nullptr, nullptr, xo); break;
            case 4: EPI_CALL(3, 1024, OX, rsq, 1.f / 1024.f, 1.f, rsq + 2 * EP_T, nullptr, xo); break;
            case 5: EPI_CALL(1, 1024, OB, rsq + 2 * EP_T, 1.f / 1024.f, 1.f, rsq + 6 * EP_T, rsq + 5 * EP_T, xo); break;
            case 6: EPI_CALL(2, 1280, OB + (32u << 20), rsq + 5 * EP_T, 1.f / 384.f, kq, nullptr, nullptr, xo); break;
            case 7: EPI_CALL(0, 1536, OB + (72u << 20), rsq + 6 * EP_T, 1.f / 256.f, 1.f, nullptr, nullptr, xo); break;
            case 8: EPI_CALL(3, 1024, OX, rsq, 1.f / 1024.f, 1.f, rsq + 3 * EP_T, nullptr, xo); break;
            case 9: EPI_CALL(4, 4096, OB, rsq + 3 * EP_T, 1.f / 1024.f, 1.f, nullptr, nullptr, xo); break;
            default: EPI_CALL(3, 1024, OX, rsq, 1.f / 1024.f, 1.f, rsq + 4 * EP_T, nullptr, xo); break;
        }
#undef EPI_CALL
    }
};
template <class Epi, class Sched, bool ALIGN_EPI = false, bool SP2 = false>
__device__ __forceinline__ void gemm_phase(PG8_LAS unsigned char* lds, const Gemm g, const Sched& S, const Epi& E) {
    int tid_ = threadIdx.x; asm volatile("" : "+v"(tid_));
    const int tid = tid_, wid = __builtin_amdgcn_readfirstlane(tid >> 6), lane = tid & 63, wr = wid >> 2, wc = wid & 3, fr = lane & 15, fq = lane >> 4;
    const int K = g.K, nt = K / BK;
    unsigned voffA[2], voffB[2];
#pragma unroll
    for (int i = 0; i < 2; ++i) { int R, C; stage_rc(tid * 16 + i * 8192, R, C); const int Rb = Epi::PERM ? ((R & ~31) + perm32(R & 31)) : R;
        voffA[i] = (unsigned)(R * g.lda + C) * 2u; voffB[i] = (unsigned)(Rb * K + C) * 2u; }
    const size_t kstep = (size_t)(BK * 2);
    const size_t hstepB = (size_t)HALF * K * 2, hstepA = (size_t)HALF * g.lda * 2;
    const size_t tstepB = 2 * hstepB, tstepA = 2 * hstepA;
    const unsigned ldsw = (unsigned)wid * 1024u;
    const int aoff = lds_byte(wr * 64 + fr, fq * 8), boff = lds_byte(wc * 32 + fr, fq * 8);
#define PG8_SA(b, h) (((b) * 2 + (h)) * HTB)
#define PG8_SB(b, h) ((4 + (b) * 2 + (h)) * HTB)
#define PG8_STAGE(bufoff, gbase, voff) do { _Pragma("unroll") for (int _i = 0; _i < 2; ++_i) \
        __builtin_amdgcn_global_load_lds((const unsigned*)((const char*)(gbase) + (voff)[_i]), (PG8_LAS unsigned*)(lds + (bufoff) + ldsw + _i * 8192), 16, 0, 0); } while (0)
#define PG8_LDA(dst, b, h) do { _Pragma("unroll") for (int m = 0; m < 4; ++m) _Pragma("unroll") for (int k = 0; k < 2; ++k) dst[m][k] = *(const PG8_LAS bf16x8*)(lds + PG8_SA(b, h) + aoff + m * 2048 + k * 1024); } while (0)
#define PG8_LDB(dst, b, h) do { _Pragma("unroll") for (int n = 0; n < 2; ++n) _Pragma("unroll") for (int k = 0; k < 2; ++k) dst[n][k] = *(const PG8_LAS bf16x8*)(lds + PG8_SB(b, h) + boff + n * 2048 + k * 1024); } while (0)
#define PG8_MMA(ai, bj, At, Bt) do { __builtin_amdgcn_s_setprio(1); _Pragma("unroll") for (int m = 0; m < 4; ++m) _Pragma("unroll") for (int n = 0; n < 2; ++n) _Pragma("unroll") for (int k = 0; k < 2; ++k) \
        acc[ai][bj][m][n] = __builtin_amdgcn_mfma_f32_16x16x32_bf16(Bt[n][k], At[m][k], acc[ai][bj][m][n], 0, 0, 0); __builtin_amdgcn_s_setprio(0); } while (0)
#define PG8_WAIT_V(n) asm volatile("s_waitcnt vmcnt(" #n ")" ::: "memory")
#define PG8_WAIT_L(n) asm volatile("s_waitcnt lgkmcnt(" #n ")" ::: "memory")
#define PG8_BAR __builtin_amdgcn_s_barrier()
#define PG8_SCHED __builtin_amdgcn_sched_barrier(0)
    Unit cur, nxt; int ui = 0;
    if (!S.next(0, cur)) return;
    f32x4 acc[2][2][4][2];
#pragma unroll
    for (int a = 0; a < 2; ++a)
#pragma unroll
        for (int b = 0; b < 2; ++b)
#pragma unroll
            for (int m = 0; m < 4; ++m)
#pragma unroll
                for (int n = 0; n < 2; ++n) acc[a][b][m][n] = (f32x4){0.f, 0.f, 0.f, 0.f};
    bf16x8 At[4][2], B0[2][2], B1[2][2];
    const char* cA = (const char*)g.A + (size_t)cur.pm * tstepA; const char* cB = (const char*)g.Bt + (size_t)cur.pn * tstepB;
    S.a_ready(cur);
    if constexpr (SP2) {
        PG8_STAGE(PG8_SB(0, 0), cB, voffB); PG8_STAGE(PG8_SB(0, 1), cB + hstepB, voffB); PG8_STAGE(PG8_SA(0, 0), cA, voffA); PG8_STAGE(PG8_SA(0, 1), cA + hstepA, voffA);
        if (wr == 1) PG8_BAR;
        PG8_WAIT_V(2); PG8_BAR;
        PG8_STAGE(PG8_SB(1, 0), cB + kstep, voffB); PG8_STAGE(PG8_SA(1, 0), cA + kstep, voffA); PG8_STAGE(PG8_SB(1, 1), cB + hstepB + kstep, voffB);
        PG8_WAIT_V(6); PG8_BAR;
    } else {
        PG8_STAGE(PG8_SB(0, 0), cB, voffB); PG8_STAGE(PG8_SA(0, 0), cA, voffA); PG8_STAGE(PG8_SB(0, 1), cB + hstepB, voffB); PG8_STAGE(PG8_SA(0, 1), cA + hstepA, voffA);
        if (wr == 1) PG8_BAR;
        PG8_WAIT_V(4); PG8_BAR;
        PG8_STAGE(PG8_SB(1, 0), cB + kstep, voffB); PG8_STAGE(PG8_SA(1, 0), cA + kstep, voffA); PG8_STAGE(PG8_SB(1, 1), cB + hstepB + kstep, voffB);
        PG8_WAIT_V(6); PG8_BAR;
    }
    for (;;) {
        const bool has_next = S.next(ui + 1, nxt);
        const char* nA = has_next ? (const char*)g.A + (size_t)nxt.pm * tstepA : cA; const char* nB = has_next ? (const char*)g.Bt + (size_t)nxt.pn * tstepB : cB;
        for (int t = 0; t < nt; t += 2) {
            const bool last = (t == nt - 2);
            const char* a1 = cA + (size_t)(t + 1) * kstep;
            const char* a2 = last ? nA : cA + (size_t)(t + 2) * kstep; const char* b2 = last ? nB : cB + (size_t)(t + 2) * kstep;
            const char* a3 = a2 + kstep; const char* b3 = b2 + kstep;
            if (last && has_next) S.a_ready(nxt);
            if constexpr (SP2) {
            PG8_LDB(B0, 0, 0); PG8_LDB(B1, 0, 1); PG8_SCHED; PG8_LDA(At, 0, 0); PG8_STAGE(PG8_SA(1, 1), a1 + hstepA, voffA);
            PG8_WAIT_V(8); PG8_WAIT_L(0); PG8_BAR; PG8_MMA(0, 0, At, B0); PG8_MMA(0, 1, At, B1); PG8_BAR; PG8_SCHED;
            PG8_LDA(At, 0, 1); PG8_STAGE(PG8_SB(0, 0), b2, voffB); PG8_STAGE(PG8_SB(0, 1), b2 + hstepB, voffB); PG8_STAGE(PG8_SA(0, 0), a2, voffA);
            PG8_WAIT_V(8); PG8_WAIT_L(0); PG8_BAR; PG8_MMA(1, 0, At, B0); PG8_MMA(1, 1, At, B1); PG8_BAR; PG8_SCHED;
            PG8_LDB(B0, 1, 0); PG8_LDB(B1, 1, 1); PG8_SCHED; PG8_LDA(At, 1, 0); PG8_STAGE(PG8_SA(0, 1), a2 + hstepA, voffA);
            PG8_WAIT_V(8); PG8_WAIT_L(0); PG8_BAR; PG8_MMA(0, 0, At, B0); PG8_MMA(0, 1, At, B1); PG8_BAR; PG8_SCHED;
            PG8_LDA(At, 1, 1); PG8_STAGE(PG8_SB(1, 0), b3, voffB); PG8_STAGE(PG8_SB(1, 1), b3 + hstepB, voffB); PG8_STAGE(PG8_SA(1, 0), a3, voffA);
            PG8_WAIT_V(8); PG8_WAIT_L(0); PG8_BAR; PG8_MMA(1, 0, At, B0); PG8_MMA(1, 1, At, B1); PG8_BAR; PG8_SCHED;
            } else {
            PG8_LDB(B0, 0, 0); PG8_SCHED; PG8_LDA(At, 0, 0); PG8_STAGE(PG8_SA(1, 1), a1 + hstepA, voffA);
            PG8_WAIT_L(8); PG8_BAR; PG8_WAIT_L(0); PG8_MMA(0, 0, At, B0); PG8_BAR; PG8_SCHED;
            PG8_LDB(B1, 0, 1); PG8_STAGE(PG8_SB(0, 0), b2, voffB);
            PG8_BAR; PG8_WAIT_L(0); PG8_MMA(0, 1, At, B1); PG8_BAR;
            PG8_LDA(At, 0, 1); PG8_STAGE(PG8_SA(0, 0), a2, voffA);
            PG8_BAR; PG8_WAIT_L(0); PG8_MMA(1, 0, At, B0); PG8_BAR; PG8_SCHED;
            PG8_STAGE(PG8_SB(0, 1), b2 + hstepB, voffB);
            PG8_WAIT_V(6); PG8_BAR; PG8_MMA(1, 1, At, B1); PG8_BAR;
            PG8_LDB(B0, 1, 0); PG8_SCHED; PG8_LDA(At, 1, 0); PG8_STAGE(PG8_SA(0, 1), a2 + hstepA, voffA);
            PG8_WAIT_L(8); PG8_BAR; PG8_WAIT_L(0); PG8_MMA(0, 0, At, B0); PG8_BAR; PG8_SCHED;
            PG8_LDB(B1, 1, 1); PG8_STAGE(PG8_SB(1, 0), b3, voffB);
            PG8_BAR; PG8_WAIT_L(0); PG8_MMA(0, 1, At, B1); PG8_BAR;
            PG8_LDA(At, 1, 1); PG8_STAGE(PG8_SA(1, 0), a3, voffA);
            PG8_BAR; PG8_WAIT_L(0); PG8_MMA(1, 0, At, B0); PG8_BAR; PG8_SCHED;
            PG8_STAGE(PG8_SB(1, 1), b3 + hstepB, voffB);
            PG8_WAIT_V(6); PG8_BAR; PG8_MMA(1, 1, At, B1); PG8_BAR;
            }
        }
        if constexpr (ALIGN_EPI) { if (wr == 0) PG8_BAR; }
        if constexpr (!Epi::AFTER_DRAIN) { E(acc, cur, wr, wc, fr, fq); S.done(cur); }
        if (!has_next) break;
#pragma unroll
        for (int a = 0; a < 2; ++a)
#pragma unroll
            for (int b = 0; b < 2; ++b)
#pragma unroll
                for (int m = 0; m < 4; ++m)
#pragma unroll
                    for (int n = 0; n < 2; ++n) acc[a][b][m][n] = (f32x4){0.f, 0.f, 0.f, 0.f};
        cur = nxt; cA = nA; cB = nB; ++ui;
        if constexpr (ALIGN_EPI) { if (wr == 1) PG8_BAR; }
    }
    PG8_WAIT_V(0);
    if constexpr (!ALIGN_EPI) { if (wr == 0) PG8_BAR; }
    PG8_BAR;
    if constexpr (Epi::AFTER_DRAIN) { E.fused(acc, cur, wr, wc, fr, fq, lds, wid, lane); S.done(cur); }
#undef PG8_SA
#undef PG8_SB
#undef PG8_STAGE
#undef PG8_LDA
#undef PG8_LDB
#undef PG8_MMA
#undef PG8_WAIT_V
#undef PG8_WAIT_L
#undef PG8_BAR
#undef PG8_SCHED
}
}
#define LAS __attribute__((address_space(3)))
#define DI __device__ __forceinline__
typedef unsigned short bf16;
typedef short bf16x8 __attribute__((ext_vector_type(8)));
typedef short s16x4 __attribute__((ext_vector_type(4)));
typedef float f32x4 __attribute__((ext_vector_type(4)));
typedef unsigned u32x4 __attribute__((ext_vector_type(4)));
typedef unsigned u32x2 __attribute__((ext_vector_type(2)));
constexpr int NTHR = 512, NWAVES = 8;
constexpr int B_ = 8, S_ = 4096, T_ = B_ * S_, D_ = 1024, FF_ = 4096;
constexpr int NMEM = 256, TM_ = B_ * NMEM;
constexpr int P0W = 2560;
constexpr int P1W = 1024;
constexpr int QW = 1280;
constexpr int KVW = 1536;
constexpr int NCH = 32;
constexpr int CT_ROWS = 208;
constexpr size_t MiB = 1u << 20;
constexpr size_t WS_ROWSQ = 0;
constexpr size_t WS_GATES = 1 * MiB;
constexpr size_t WS_CS = 2 * MiB;
constexpr size_t WS_SCAL = 6 * MiB;
constexpr size_t WS_MPREV = 6 * MiB + 65536;
constexpr size_t WS_MEMKV = 8 * MiB;
constexpr size_t WS_MEMBF = 10 * MiB;
constexpr size_t WS_WIN0 = 16 * MiB, WS_WMEM = 21 * MiB, WS_WOUT0 = 22 * MiB, WS_WFF1_0 = 24 * MiB, WS_WFF2_0 = 32 * MiB, WS_WIN1 = 40 * MiB,
                 WS_WUQ = 42 * MiB, WS_WUKV = 43 * MiB, WS_WOUT1 = 44 * MiB, WS_WFF1_1 = 46 * MiB, WS_WFF2_1 = 54 * MiB;
constexpr size_t WS_XB = 64 * MiB;
constexpr size_t WS_Y = 128 * MiB;
constexpr size_t WS_CT = 192 * MiB;
constexpr size_t WS_BIG = 232 * MiB;
constexpr size_t WS_END = 488 * MiB;
constexpr int LDS_BYTES = 147456;

DI float bf2f(unsigned short h) { return __uint_as_float(((unsigned)h) << 16); }
DI unsigned short f2bf(float f) { return __builtin_bit_cast(unsigned short, (__bf16)f); }
typedef float f32x2 __attribute__((ext_vector_type(2)));
typedef __bf16 bf16x2_t __attribute__((ext_vector_type(2)));
DI unsigned pk2(float lo, float hi) { const f32x2 v = {lo, hi}; return __builtin_bit_cast(unsigned, __builtin_convertvector(v, bf16x2_t)); }
DI float wave_sum(float v) {
#pragma unroll
    for (int o = 1; o < 64; o <<= 1) v += __shfl_xor(v, o);
    return v;
}
DI float xor32_max(float x) { const auto r = __builtin_amdgcn_permlane32_swap(__float_as_uint(x), __float_as_uint(x), false, false); return fmaxf(__uint_as_float(r[0]), __uint_as_float(r[1])); }
DI float xor32_sum(float x) { const auto r = __builtin_amdgcn_permlane32_swap(__float_as_uint(x), __float_as_uint(x), false, false); return __uint_as_float(r[0]) + __uint_as_float(r[1]); }
DI float silu(float x) { return x * __builtin_amdgcn_rcpf(1.f + __expf(-x)); }
#define LDS_WAIT() asm volatile("s_waitcnt lgkmcnt(0)" ::: "memory")
#define MFMA16(a, b, c) __builtin_amdgcn_mfma_f32_16x16x32_bf16((a), (b), (c), 0, 0, 0)

typedef KArgs Args;
DI const float* inp(const Args& a, int i) { asm volatile("" : "+s"(i)); return a.in[i]; }
enum { I_X = 0, I_MEM, I_POS, I_MEMNORM, I_WMEMKV, I_NORMMIX0, I_WIN0, I_BI, I_BF, I_WCONV, I_WHNORM, I_WOUT0, I_NORMFFN0, I_WFF1_0, I_WFF2_0,
       I_NORMMIX1, I_WIN1, I_WQNORM, I_WUQ, I_WKVNORM, I_WUKV, I_WOUT1, I_NORMFFN1, I_WFF1_1, I_WFF2_1, I_FINALNORM };

DI int srccol(int map, int n) {
    if (map == 1) return n < 2304 ? n : n + 8;
    if (map == 2) {
        if (n < 256) return 384 + n;
        if (n < 640) return n - 256;
        if (n < 672) { const int j = n - 640; return 640 + (j & 1) * 16 + (j >> 1); }
        if (n < 768) return -1;
        return 672 + (n - 768);
    }
    if (map == 3) {
        if (n >= 1152) return -1;
        const int h = n / 96, j = n % 96;
        if (j < 64) return h * 96 + j;
        const int jj = j - 64; return h * 96 + 64 + (jj & 1) * 16 + (jj >> 1);
    }
    return n;
}
DI void cvt_item(const float* W, int K, int Nsrc, int Ndst, int map, const float* gain, bf16* WT, LAS float* scr, int item, int lane) {
    const int nblk = Ndst / 32, kb = item / nblk, nb = item % nblk, k0 = 64 * kb, n0 = 32 * nb;
    const int sc = srccol(map, n0 + (lane & 31));
    float wv[32];
#pragma unroll
    for (int i = 0; i < 32; ++i) { const int kk = 2 * i + (lane >> 5); wv[i] = (sc >= 0) ? W[(size_t)(k0 + kk) * Nsrc + sc] : 0.f; }
    const int c = lane & 7;
    f32x4 g0 = (f32x4){1.f, 1.f, 1.f, 1.f}, g1 = g0;
    if (gain) { g0 = *(const f32x4*)(gain + k0 + 8 * c); g1 = *(const f32x4*)(gain + k0 + 8 * c + 4); }
#pragma unroll
    for (int i = 0; i < 32; ++i) { const int kk = 2 * i + (lane >> 5); scr[kk * 33 + (lane & 31)] = wv[i]; }
    LDS_WAIT(); asm volatile("" ::: "memory");
#pragma unroll
    for (int j = 0; j < 4; ++j) { const int n = (lane >> 3) + 8 * j; const LAS float* s = scr + (8 * c) * 33 + n;
        u32x4 o; o.x = pk2(s[0 * 33] * g0.x, s[1 * 33] * g0.y); o.y = pk2(s[2 * 33] * g0.z, s[3 * 33] * g0.w); o.z = pk2(s[4 * 33] * g1.x, s[5 * 33] * g1.y); o.w = pk2(s[6 * 33] * g1.z, s[7 * 33] * g1.w);
        *(u32x4*)(WT + (size_t)(n0 + n) * K + k0 + 8 * c) = o; }
    LDS_WAIT(); asm volatile("" ::: "memory");
}
DI float logsigmoid(float z) { return fminf(z, 0.f) - __logf(1.f + __expf(-fabsf(z))); }

DI void p0_prologue(const Args& a, LAS unsigned char* lds, int gw, int NGW, int lane, int wave, int tid) {
    __attribute__((address_space(1))) unsigned char* wsg_ = (__attribute__((address_space(1))) unsigned char*)a.ws; asm volatile("" : "+s"(wsg_)); unsigned char* ws = (unsigned char*)wsg_;
    LAS float* scr = (LAS float*)(lds + wave * 8448);
    LAS float* gwl = (LAS float*)(lds + 73728);
    { const float* W = inp(a, I_WIN0); const float* g = inp(a, I_NORMMIX0);
      for (int e = tid; e < 1024 * 8; e += NTHR) { const int k = e >> 3, c = e & 7; gwl[(((((k >> 8) * 4 + (k & 3)) * 2 + (c >> 2)) * 64 + ((k & 255) >> 2)) << 2) + (c & 3)] = W[(size_t)k * 2568 + 2304 + c] * g[k]; } }
#define CV(W_, K_, NS_, ND_, MAP_, G_, OFF_) { constexpr int items = (K_ / 64) * (ND_ / 32); if (r < items) { cvt_item(inp(a, W_), K_, NS_, ND_, MAP_, (G_) >= 0 ? inp(a, (G_) >= 0 ? (G_) : 0) : nullptr, (bf16*)(ws + OFF_), scr, r, lane); continue; } r -= items; }
    constexpr int NITEMS = 16 * 80 + 16 * 16 + 16 * 32 + 16 * 128 + 64 * 32 + 16 * 32 + 6 * 40 + 4 * 48 + 16 * 32 + 16 * 128 + 64 * 32;
    for (int it = gw; it < NITEMS; it += NGW) {
        int r = it;
        CV(I_WIN0, 1024, 2568, 2560, 1, I_NORMMIX0, WS_WIN0)
        CV(I_WMEMKV, 1024, 512, 512, 0, I_MEMNORM, WS_WMEM)
        CV(I_WOUT0, 1024, 1024, 1024, 0, -1, WS_WOUT0)
        CV(I_WFF1_0, 1024, 4096, 4096, 0, I_NORMFFN0, WS_WFF1_0)
        CV(I_WFF2_0, 4096, 1024, 1024, 0, -1, WS_WFF2_0)
        CV(I_WIN1, 1024, 928, 1024, 2, I_NORMMIX1, WS_WIN1)
        CV(I_WUQ, 384, 1152, 1280, 3, I_WQNORM, WS_WUQ)
        CV(I_WUKV, 256, 1536, 1536, 0, I_WKVNORM, WS_WUKV)
        CV(I_WOUT1, 1024, 1024, 1024, 0, -1, WS_WOUT1)
        CV(I_WFF1_1, 1024, 4096, 4096, 0, I_NORMFFN1, WS_WFF1_1)
        CV(I_WFF2_1, 4096, 1024, 1024, 0, -1, WS_WFF2_1)
    }
#undef CV
    __syncthreads();
    float* rowsq = (float*)(ws + WS_ROWSQ); float* gates = (float*)(ws + WS_GATES);
    const float* bi = inp(a, I_BI); const float* bfg = inp(a, I_BF);
    for (int m0 = gw; m0 < T_; m0 += 2 * NGW) {
        f32x4 xv[2][4];
#pragma unroll
        for (int rr = 0; rr < 2; ++rr) { const int m = min(m0 + rr * NGW, T_ - 1); const f32x4* xr = (const f32x4*)(inp(a, I_X) + (size_t)m * D_) + lane;
#pragma unroll
                for (int j = 0; j < 4; ++j) xv[rr][j] = xr[64 * j]; }
#pragma unroll
        for (int rr = 0; rr < 2; ++rr) { const int m = m0 + rr * NGW; if (m < T_) {
            unsigned long long* o8 = (unsigned long long*)((bf16*)(ws + WS_XB) + (size_t)m * D_) + lane;
            float s = 0.f, g8[8];
#pragma unroll
            for (int j = 0; j < 8; ++j) g8[j] = 0.f;
#pragma unroll
            for (int j = 0; j < 4; ++j) { const f32x4 v = xv[rr][j]; s += (v.x * v.x + v.y * v.y) + (v.z * v.z + v.w * v.w);
                o8[64 * j] = (unsigned long long)pk2(v.x, v.y) | ((unsigned long long)pk2(v.z, v.w) << 32);
                const LAS f32x4* gq = (const LAS f32x4*)gwl + (j * 8) * 64 + lane;
#pragma unroll
                for (int e = 0; e < 4; ++e) { const f32x4 w0 = gq[(2 * e) * 64], w1 = gq[(2 * e + 1) * 64]; const float xe = v[e];
                    g8[0] += xe * w0.x; g8[1] += xe * w0.y; g8[2] += xe * w0.z; g8[3] += xe * w0.w; g8[4] += xe * w1.x; g8[5] += xe * w1.y; g8[6] += xe * w1.z; g8[7] += xe * w1.w; } }
            s = wave_sum(s);
#pragma unroll
            for (int j = 0; j < 8; ++j) g8[j] = wave_sum(g8[j]);
            const float rstd = rsqrtf(s * (1.f / D_) + RMS_EPS);
            if (lane == 0) rowsq[m] = s;
            if (lane < 8) { float gv = g8[0];
#pragma unroll
                for (int j = 1; j < 8; ++j) gv = (lane == j) ? g8[j] : gv;
                gv *= rstd;
                gates[(size_t)m * 8 + lane] = (lane < 4) ? gv + bi[lane] : logsigmoid(gv + bfg[lane - 4]); }
        } }
    }
    for (int m = gw; m < TM_; m += NGW) {
        const f32x4* xr = (const f32x4*)(inp(a, I_MEM) + (size_t)m * D_) + lane;
        unsigned long long* o8 = (unsigned long long*)((bf16*)(ws + WS_MEMBF) + (size_t)m * D_) + lane;
        float s = 0.f;
#pragma unroll
        for (int j = 0; j < 4; ++j) { const f32x4 v = xr[64 * j]; s += (v.x * v.x + v.y * v.y) + (v.z * v.z + v.w * v.w);
            o8[64 * j] = (unsigned long long)pk2(v.x, v.y) | ((unsigned long long)pk2(v.z, v.w) << 32); }
        s = wave_sum(s);
        if (lane == 0) rowsq[7 * T_ + m] = s;
    }
    const int gt = gw * 64 + lane, NGT = NGW * 64;
    for (int i = gt; i < 6 * T_; i += NGT) rowsq[T_ + i] = 0.f;
    { const int* pos = (const int*)inp(a, I_POS); float* cs = (float*)(ws + WS_CS);
      for (int i = gt; i < T_ * 16; i += NGT) { const int t = i >> 4, p = i & 15;
          const float inv = exp2f(-(float)p * (13.287712379549449f / 16.f));
          const float ang = (float)pos[t] * inv;
          double rev = (double)ang * 0.15915494309189535; rev -= floor(rev);
          const float rv = (float)rev;
          cs[2 * i] = __builtin_amdgcn_cosf(rv); cs[2 * i + 1] = __builtin_amdgcn_sinf(rv); } }
}
DI void conv8(const bf16* P0, const float* wconv, size_t t, int spos, int ch0, float (&o)[8]) {
#pragma unroll
    for (int i = 0; i < 8; ++i) o[i] = 0.f;
#pragma unroll
    for (int j = 0; j < 4; ++j) {
        const int dt = j - 3;
        if (spos + dt >= 0) {
            const u32x4 raw = *(const u32x4*)(P0 + (size_t)((long)t + dt) * P0W + ch0);
            const f32x4 w0 = *(const f32x4*)(wconv + j * 768 + ch0), w1 = *(const f32x4*)(wconv + j * 768 + ch0 + 4);
            o[0] += w0.x * __uint_as_float(raw.x << 16); o[1] += w0.y * __uint_as_float(raw.x & 0xffff0000u);
            o[2] += w0.z * __uint_as_float(raw.y << 16); o[3] += w0.w * __uint_as_float(raw.y & 0xffff0000u);
            o[4] += w1.x * __uint_as_float(raw.z << 16); o[5] += w1.y * __uint_as_float(raw.z & 0xffff0000u);
            o[6] += w1.z * __uint_as_float(raw.w << 16); o[7] += w1.w * __uint_as_float(raw.w & 0xffff0000u);
        }
    }
#pragma unroll
    for (int i = 0; i < 8; ++i) o[i] = silu(o[i]);
}
constexpr float KSCALE = 0.10206207261596575f;

DI void mlstm_local_unit(const Args& a, LAS unsigned char* lds, int unit, int tid, int lane, int wave) {
    __attribute__((address_space(1))) unsigned char* wsg_ = (__attribute__((address_space(1))) unsigned char*)a.ws; asm volatile("" : "+s"(wsg_)); unsigned char* ws = (unsigned char*)wsg_;
    const int bh = unit >> 5, c = unit & 31, b = bh >> 2, h = bh & 3;
    const size_t t0 = (size_t)b * S_ + (size_t)c * 128;
    const bf16* P0 = (const bf16*)(ws + WS_BIG);
    const float* gates = (const float*)(ws + WS_GATES);
    LAS float* su = (LAS float*)lds;
    LAS bf16* Kt = (LAS bf16*)(lds + 1024);
    LAS bf16* Vt = (LAS bf16*)(lds + 1024 + 96 * 272);
    const int s = tid & 127, gq = tid >> 7;
    LAS bf16* Rw = (LAS bf16*)(lds + 1024 + 96 * 272 + 192 * 272);
    u32x4 rvv[6];
#pragma unroll
    for (int r = 0; r < 6; ++r) rvv[r] = *(const u32x4*)(P0 + (t0 + s) * P0W + 768 + h * 192 + (gq + 4 * r) * 8);
    { u32x4 rr[7];
#pragma unroll
      for (int i = 0; i < 7; ++i) { const int e = min(tid + NTHR * i, 131 * 24 - 1), row = e / 24, cg = e % 24;
          const long tr = (long)t0 - 3 + row; const bool ok_ = (c * 128 - 3 + row) >= 0;
          rr[i] = ok_ ? *(const u32x4*)(P0 + (size_t)(ok_ ? tr : 0) * P0W + (cg < 12 ? h * 96 + cg * 8 : 384 + h * 96 + (cg - 12) * 8)) : (u32x4){0u, 0u, 0u, 0u}; }
#pragma unroll
      for (int i = 0; i < 7; ++i) { const int e = tid + NTHR * i; if (e < 131 * 24) *(LAS u32x4*)(Rw + (e / 24) * 200 + (e % 24) * 8) = rr[i]; } }
    if (wave == 0) {
        const float lf0 = gates[(t0 + 2 * lane) * 8 + 4 + h], lf1 = gates[(t0 + 2 * lane + 1) * 8 + 4 + h];
        const float li0 = gates[(t0 + 2 * lane) * 8 + h], li1 = gates[(t0 + 2 * lane + 1) * 8 + h];
        float p = lf0 + lf1;
#pragma unroll
        for (int o = 1; o < 64; o <<= 1) { const float q = __shfl_up(p, o); if (lane >= o) p += q; }
        const float b1 = p, b0 = p - lf1;
        const float g0 = li0 - b0, g1 = li1 - b1;
        float gm = fmaxf(g0, g1);
#pragma unroll
        for (int o = 1; o < 64; o <<= 1) gm = fmaxf(gm, __shfl_xor(gm, o));
        su[2 * lane] = __expf(g0 - gm); su[2 * lane + 1] = __expf(g1 - gm);
        const float bend = __shfl(b1, 63);
        if (lane == 0) { float* sc = (float*)(ws + WS_SCAL) + 2 * unit; sc[0] = bend; sc[1] = bend + gm; }
    }
    __syncthreads();
    bf16* QKc = (bf16*)(ws + WS_XB) + (t0 + s) * 768 + h * 96;
    const float us = su[s];
    const float* wconv = inp(a, I_WCONV);
#pragma unroll
    for (int r = 0; r < 6; ++r) {
        const int cg = gq + 4 * r, isk = cg >= 12, dg = isk ? cg - 12 : cg, ch0 = (isk ? 384 : 0) + h * 96 + dg * 8;
        float o[8];
#pragma unroll
        for (int i = 0; i < 8; ++i) o[i] = 0.f;
#pragma unroll
        for (int j = 0; j < 4; ++j) {
            const u32x4 raw = *(const LAS u32x4*)(Rw + (s + j) * 200 + cg * 8);
            const f32x4 w0 = *(const f32x4*)(wconv + j * 768 + ch0), w1 = *(const f32x4*)(wconv + j * 768 + ch0 + 4);
            o[0] += w0.x * __uint_as_float(raw.x << 16); o[1] += w0.y * __uint_as_float(raw.x & 0xffff0000u);
            o[2] += w0.z * __uint_as_float(raw.y << 16); o[3] += w0.w * __uint_as_float(raw.y & 0xffff0000u);
            o[4] += w1.x * __uint_as_float(raw.z << 16); o[5] += w1.y * __uint_as_float(raw.z & 0xffff0000u);
            o[6] += w1.z * __uint_as_float(raw.w << 16); o[7] += w1.w * __uint_as_float(raw.w & 0xffff0000u);
        }
        const float ksc = isk ? KSCALE : 1.f;
#pragma unroll
        for (int i = 0; i < 8; ++i) o[i] = silu(o[i]) * ksc;
        u32x4 w; w.x = pk2(o[0], o[1]); w.y = pk2(o[2], o[3]); w.z = pk2(o[4], o[5]); w.w = pk2(o[6], o[7]); *(u32x4*)(QKc + (isk ? 384 : 0) + dg * 8) = w;
        if (isk) {
#pragma unroll
            for (int i = 0; i < 8; ++i) Kt[(dg * 8 + i) * 136 + s] = f2bf(o[i] * us); }
    }
#pragma unroll
    for (int r = 0; r < 6; ++r) {
        const int vg = gq + 4 * r; const u32x4 raw = rvv[r];
        Vt[(vg * 8 + 0) * 136 + s] = (bf16)(raw.x & 0xffff); Vt[(vg * 8 + 1) * 136 + s] = (bf16)(raw.x >> 16);
        Vt[(vg * 8 + 2) * 136 + s] = (bf16)(raw.y & 0xffff); Vt[(vg * 8 + 3) * 136 + s] = (bf16)(raw.y >> 16);
        Vt[(vg * 8 + 4) * 136 + s] = (bf16)(raw.z & 0xffff); Vt[(vg * 8 + 5) * 136 + s] = (bf16)(raw.z >> 16);
        Vt[(vg * 8 + 6) * 136 + s] = (bf16)(raw.w & 0xffff); Vt[(vg * 8 + 7) * 136 + s] = (bf16)(raw.w >> 16);
    }
    __syncthreads();
    float* U = (float*)(ws + WS_BIG + 160 * MiB) + (size_t)unit * (193 * 96);
    if (tid < 384) {
        const int d = tid >> 2, part = tid & 3; float sum = 0.f;
#pragma unroll 8
        for (int i = 0; i < 32; ++i) sum += bf2f(Kt[d * 136 + part * 32 + i]);
        sum += __shfl_xor(sum, 1); sum += __shfl_xor(sum, 2);
        if (part == 0) U[192 * 96 + d] = sum;
    }
    {
        const int dgp = wave & 1, vgp = wave >> 1, r16 = lane & 15, g = lane >> 4;
        f32x4 acc[3][3];
#pragma unroll
        for (int i = 0; i < 3; ++i)
#pragma unroll
            for (int j = 0; j < 3; ++j) acc[i][j] = (f32x4){0.f, 0.f, 0.f, 0.f};
#pragma unroll
        for (int ks = 0; ks < 4; ++ks) {
            bf16x8 af[3], bfr[3];
#pragma unroll
            for (int i = 0; i < 3; ++i) af[i] = *(const LAS bf16x8*)(Kt + ((dgp * 3 + i) * 16 + r16) * 136 + ks * 32 + g * 8);
#pragma unroll
            for (int j = 0; j < 3; ++j) bfr[j] = *(const LAS bf16x8*)(Vt + ((vgp * 3 + j) * 16 + r16) * 136 + ks * 32 + g * 8);
#pragma unroll
            for (int i = 0; i < 3; ++i)
#pragma unroll
                for (int j = 0; j < 3; ++j) acc[i][j] = MFMA16(af[i], bfr[j], acc[i][j]);
        }
#pragma unroll
        for (int i = 0; i < 3; ++i)
#pragma unroll
            for (int j = 0; j < 3; ++j) *(f32x4*)(U + (size_t)((vgp * 3 + j) * 16 + r16) * 96 + (dgp * 3 + i) * 16 + g * 4) = acc[i][j];
    }
    __syncthreads();
}

DI void memattn_unit(const Args& a, LAS unsigned char* lds, const bf16* Qp, int ldq, int qcol0, int unit, int tid, int lane, int wave) {
    __attribute__((address_space(1))) unsigned char* wsg_ = (__attribute__((address_space(1))) unsigned char*)a.ws; asm volatile("" : "+s"(wsg_)); unsigned char* ws = (unsigned char*)wsg_;
    const int rb4 = unit & 7, bh = unit >> 3, b = bh >> 2, h = bh & 3;
    const bf16* MKV = (const bf16*)(ws + WS_MEMKV) + (size_t)b * NMEM * 512;
    LAS bf16* Km = (LAS bf16*)lds;
    LAS bf16* Vt = (LAS bf16*)(lds + 36864);
    LAS bf16* Qs = (LAS bf16*)(lds + 36864 + 33792);
#pragma unroll
    for (int r = 0; r < 4; ++r) { const int gi = tid + NTHR * r, key = gi >> 3, dg = gi & 7;
        *(LAS u32x4*)(Km + key * 72 + dg * 8) = *(const u32x4*)(MKV + (size_t)key * 512 + h * 64 + dg * 8); }
#pragma unroll
    for (int r = 0; r < 4; ++r) { const int gi = tid + NTHR * r, key = gi & 255, vg = gi >> 8;
        const u32x4 raw = *(const u32x4*)(MKV + (size_t)key * 512 + 256 + h * 64 + vg * 8);
        Vt[(vg * 8 + 0) * 264 + key] = (bf16)(raw.x & 0xffff); Vt[(vg * 8 + 1) * 264 + key] = (bf16)(raw.x >> 16);
        Vt[(vg * 8 + 2) * 264 + key] = (bf16)(raw.y & 0xffff); Vt[(vg * 8 + 3) * 264 + key] = (bf16)(raw.y >> 16);
        Vt[(vg * 8 + 4) * 264 + key] = (bf16)(raw.z & 0xffff); Vt[(vg * 8 + 5) * 264 + key] = (bf16)(raw.z >> 16);
        Vt[(vg * 8 + 6) * 264 + key] = (bf16)(raw.w & 0xffff); Vt[(vg * 8 + 7) * 264 + key] = (bf16)(raw.w >> 16); }
#pragma unroll 1
    for (int sb = 0; sb < 4; ++sb) {
    const size_t t0 = (size_t)b * S_ + (size_t)(rb4 * 4 + sb) * 128;
#pragma unroll
    for (int r = 0; r < 2; ++r) { const int gi = tid + NTHR * r, q = gi >> 3, dg = gi & 7;
        *(LAS u32x4*)(Qs + q * 72 + dg * 8) = *(const u32x4*)(Qp + (t0 + q) * ldq + qcol0 + h * 64 + dg * 8); }
    __syncthreads();
    const int r16 = lane & 15, g = lane >> 4, q0 = wave * 16;
    bf16x8 qf[2];
#pragma unroll
    for (int ks = 0; ks < 2; ++ks) qf[ks] = *(const LAS bf16x8*)(Qs + (q0 + r16) * 72 + ks * 32 + g * 8);
    f32x4 sc[16];
#pragma unroll
    for (int kt = 0; kt < 16; ++kt) { sc[kt] = (f32x4){0.f, 0.f, 0.f, 0.f};
#pragma unroll
        for (int ks = 0; ks < 2; ++ks) { const bf16x8 kf = *(const LAS bf16x8*)(Km + (kt * 16 + r16) * 72 + ks * 32 + g * 8); sc[kt] = MFMA16(kf, qf[ks], sc[kt]); } }
    float mx = -INFINITY;
#pragma unroll
    for (int kt = 0; kt < 16; ++kt) mx = fmaxf(mx, fmaxf(fmaxf(sc[kt][0], sc[kt][1]), fmaxf(sc[kt][2], sc[kt][3])));
    mx = fmaxf(mx, __shfl_xor(mx, 16)); mx = xor32_max(mx);
    const float c2 = 0.125f * 1.4426950408889634f; float sum = 0.f;
#pragma unroll
    for (int kt = 0; kt < 16; ++kt)
#pragma unroll
        for (int i = 0; i < 4; ++i) { const float p = __builtin_amdgcn_exp2f((sc[kt][i] - mx) * c2); sc[kt][i] = p; sum += p; }
    sum += __shfl_xor(sum, 16); sum = xor32_sum(sum);
    f32x4 oa[4];
#pragma unroll
    for (int vt = 0; vt < 4; ++vt) oa[vt] = (f32x4){0.f, 0.f, 0.f, 0.f};
#pragma unroll
    for (int k2 = 0; k2 < 8; ++k2) {
        u32x4 pw; pw.x = pk2(sc[2 * k2][0], sc[2 * k2][1]); pw.y = pk2(sc[2 * k2][2], sc[2 * k2][3]); pw.z = pk2(sc[2 * k2 + 1][0], sc[2 * k2 + 1][1]); pw.w = pk2(sc[2 * k2 + 1][2], sc[2 * k2 + 1][3]);
        const bf16x8 pf = __builtin_bit_cast(bf16x8, pw);
#pragma unroll
        for (int vt = 0; vt < 4; ++vt) {
            const s16x4 lo = *(const LAS s16x4*)(Vt + (vt * 16 + r16) * 264 + 32 * k2 + g * 4), hi = *(const LAS s16x4*)(Vt + (vt * 16 + r16) * 264 + 32 * k2 + 16 + g * 4);
            const bf16x8 vf = __builtin_shufflevector(lo, hi, 0, 1, 2, 3, 4, 5, 6, 7);
            oa[vt] = MFMA16(vf, pf, oa[vt]);
        }
    }
    const float inv = 1.f / sum;
    bf16* Y = (bf16*)(ws + WS_Y) + (t0 + q0 + r16) * D_ + 768 + h * 64;
#pragma unroll
    for (int vt = 0; vt < 4; ++vt) { u32x2 w; w.x = pk2(oa[vt][0] * inv, oa[vt][1] * inv); w.y = pk2(oa[vt][2] * inv, oa[vt][3] * inv); *(u32x2*)(Y + vt * 16 + g * 4) = w; }
    __syncthreads();
    }
}

DI void mlstm_scan(const Args& a, int gt, int NGT) {
    __attribute__((address_space(1))) unsigned char* wsg_ = (__attribute__((address_space(1))) unsigned char*)a.ws; asm volatile("" : "+s"(wsg_)); unsigned char* ws = (unsigned char*)wsg_;
    const float* U = (const float*)(ws + WS_BIG + 160 * MiB);
    bf16* Ct = (bf16*)(ws + WS_CT);
    const float* scal = (const float*)(ws + WS_SCAL);
    float* mprev = (float*)(ws + WS_MPREV);
    constexpr int NE = 193 * 96, NE4 = NE / 4;
    for (int idx = gt; idx < 32 * NE4; idx += NGT) {
        const int bh = idx / NE4, e = (idx - bh * NE4) * 4;
        float m = 0.f; f32x4 C = (f32x4){0.f, 0.f, 0.f, 0.f};
        f32x4 u[NCH];
#pragma unroll
        for (int c = 0; c < NCH; ++c) u[c] = *(const f32x4*)(U + (size_t)(bh * NCH + c) * NE + e);
#pragma unroll
        for (int c = 0; c < NCH; ++c) {
            const int unit = bh * NCH + c;
            const float be = scal[2 * unit], ml = scal[2 * unit + 1];
            const float mn = fmaxf(be + m, ml), dec = __expf(be + m - mn), sc = __expf(ml - mn);
            u32x2 w; w.x = pk2(C[0], C[1]); w.y = pk2(C[2], C[3]);
            *(u32x2*)(Ct + (size_t)unit * (CT_ROWS * 96) + e) = w;
            if (e == 0) mprev[unit] = m;
            C = C * dec + u[c] * sc;
            m = mn;
        }
    }
    for (int idx = gt; idx < 1024 * 15 * 96; idx += NGT) { const int unit = idx / (15 * 96), e = idx - unit * (15 * 96); Ct[(size_t)unit * (CT_ROWS * 96) + 193 * 96 + e] = 0; }
}
DI void mlstm_out_phase(const Args& a, LAS unsigned char* lds, int bx, int G, int tid_in) {
    u32x4 rq[2], rkk[3], rvv[6], rct[5]; float rg[4], rmp;
#define MLO_LOADS(u2_) do { const int rh_ = (u2_) & 1, un_ = (u2_) >> 1, bh_ = un_ >> 5, c_ = un_ & 31, b_ = bh_ >> 2, h_ = bh_ & 3; const size_t t0_ = (size_t)b_ * S_ + (size_t)c_ * 128; \
        _Pragma("unroll") for (int i = 0; i < 2; ++i) { const int e = min(tid + NTHR * i, 767); rq[i] = *(const u32x4*)(QKc + (t0_ + rh_ * 64 + e / 12) * 768 + h_ * 96 + (e % 12) * 8); } \
        _Pragma("unroll") for (int i = 0; i < 3; ++i) { const int e = tid + NTHR * i; rkk[i] = *(const u32x4*)(QKc + (t0_ + e / 12) * 768 + 384 + h_ * 96 + (e % 12) * 8); } \
        _Pragma("unroll") for (int r = 0; r < 6; ++r) rvv[r] = *(const u32x4*)(P0 + (t0_ + (tid & 127)) * P0W + 768 + h_ * 192 + ((tid >> 7) + 4 * r) * 8); \
        { const float* gt_ = (const float*)(ws + WS_GATES) + (t0_ + 2 * (tid & 63)) * 8 + h_; rg[0] = gt_[4]; rg[1] = gt_[12]; rg[2] = gt_[0]; rg[3] = gt_[8]; rmp = ((const float*)(ws + WS_MPREV))[un_]; } \
        { const bf16* Ct_ = (const bf16*)(ws + WS_CT) + (size_t)un_ * (CT_ROWS * 96); \
          _Pragma("unroll") for (int i = 0; i < 5; ++i) { const int e = min(tid + NTHR * i, CT_ROWS * 12 - 1); rct[i] = *(const u32x4*)(Ct_ + e * 8); } } } while (0)
    { __attribute__((address_space(1))) unsigned char* wsg0_ = (__attribute__((address_space(1))) unsigned char*)a.ws; asm volatile("" : "+s"(wsg0_)); unsigned char* ws = (unsigned char*)wsg0_;
      const int tid = tid_in; const bf16* P0 = (const bf16*)(ws + WS_BIG); const bf16* QKc = (const bf16*)(ws + WS_XB);
      MLO_LOADS(min(bx, 2047)); }
#pragma unroll 1
    for (int unit2 = bx; unit2 < 2048; unit2 += G) {
    __attribute__((address_space(1))) unsigned char* wsg_ = (__attribute__((address_space(1))) unsigned char*)a.ws; asm volatile("" : "+s"(wsg_)); unsigned char* ws = (unsigned char*)wsg_;
    int tid = tid_in; asm volatile("" : "+v"(tid)); const int lane = tid & 63, wave = tid >> 6;
    const int rh = unit2 & 1, unit = unit2 >> 1, bh = unit >> 5, c = unit & 31, b = bh >> 2, h = bh & 3;
    const size_t t0 = (size_t)b * S_ + (size_t)c * 128;
    const bf16* P0 = (const bf16*)(ws + WS_BIG);
    const bf16* QKc = (const bf16*)(ws + WS_XB);
    LAS float* sM = (LAS float*)lds;
    LAS float* sA = sM + 64;
    LAS float* sE = sM + 128;
    LAS float* sG = sM + 192;
    LAS float* sD = sM + 320;
    LAS float* sQ = sM + 384;
    LAS bf16* A2 = (LAS bf16*)(lds + 4096);
    LAS bf16* B2 = (LAS bf16*)(lds + 4096 + 64 * 464);
    LAS bf16* Ks = B2;
    LAS bf16* Yt = A2;
    const int sv = tid & 127, gq = tid >> 7;
    if (wave == 0) {
        const float lf0 = rg[0], lf1 = rg[1], li0 = rg[2], li1 = rg[3];
        float p = lf0 + lf1;
#pragma unroll
        for (int o = 1; o < 64; o <<= 1) { const float q = __shfl_up(p, o); if (lane >= o) p += q; }
        const float b1 = p, b0 = p - lf1;
        const float g0 = li0 - b0, g1 = li1 - b1;
        float pm = fmaxf(g0, g1);
#pragma unroll
        for (int o = 1; o < 64; o <<= 1) { const float q = __shfl_up(pm, o); if (lane >= o) pm = fmaxf(pm, q); }
        float pmx = __shfl_up(pm, 1); if (lane == 0) pmx = -INFINITY;
        const float pm0 = fmaxf(pmx, g0), pm1 = pm;
        sG[2 * lane] = g0; sG[2 * lane + 1] = g1;
        const float mp = rmp;
        const int jl = 2 * lane - rh * 64;
        if (jl >= 0 && jl < 64) {
            const float M0 = fmaxf(mp, pm0), M1 = fmaxf(mp, pm1);
            sM[jl] = M0; sM[jl + 1] = M1; sA[jl] = __expf(mp - M0); sA[jl + 1] = __expf(mp - M1);
            sE[jl] = __expf(-(b0 + M0)); sE[jl + 1] = __expf(-(b1 + M1));
        }
    }
#pragma unroll
    for (int i = 0; i < 2; ++i) { const int e = tid + NTHR * i; if (e < 768) *(LAS u32x4*)(A2 + (e / 12) * 232 + 128 + (e % 12) * 8) = rq[i]; }
#pragma unroll
    for (int i = 0; i < 3; ++i) { const int e = tid + NTHR * i; *(LAS u32x4*)(Ks + (e / 12) * 104 + (e % 12) * 8) = rkk[i]; }
    __syncthreads();
    const int r16 = lane & 15, g = lane >> 4, rt = wave & 3, wh = wave >> 2;
    {
        f32x4 sacc[4];
#pragma unroll
        for (int j = 0; j < 4; ++j) sacc[j] = (f32x4){0.f, 0.f, 0.f, 0.f};
#pragma unroll
        for (int ks = 0; ks < 3; ++ks) {
            const bf16x8 qf = *(const LAS bf16x8*)(A2 + (rt * 16 + r16) * 232 + 128 + ks * 32 + g * 8);
#pragma unroll
            for (int j = 0; j < 4; ++j) { const bf16x8 kf = *(const LAS bf16x8*)(Ks + ((wh * 4 + j) * 16 + r16) * 104 + ks * 32 + g * 8); sacc[j] = MFMA16(qf, kf, sacc[j]); }
        }
#pragma unroll
        for (int j = 0; j < 4; ++j) { const int s = (wh * 4 + j) * 16 + r16; const float gs = sG[s];
#pragma unroll
            for (int i = 0; i < 4; ++i) { const int jl = rt * 16 + g * 4 + i; const float w = (s <= rh * 64 + jl) ? __expf(gs - sM[jl]) : 0.f; A2[jl * 232 + s] = f2bf(sacc[j][i] * w); } }
    }
    __syncthreads();
    for (int e = tid; e < 64 * 48; e += NTHR) { const int r = e / 48, cp = e % 48; LAS unsigned* p = (LAS unsigned*)(A2 + r * 232 + 128) + cp; const unsigned v = *p; const float s = sA[r];
        *p = pk2(__uint_as_float(v << 16) * s, __uint_as_float(v & 0xffff0000u) * s); }
#pragma unroll
    for (int r = 0; r < 6; ++r) { const int vg = gq + 4 * r; const u32x4 raw = rvv[r];
        B2[(vg * 8 + 0) * 232 + sv] = (bf16)(raw.x & 0xffff); B2[(vg * 8 + 1) * 232 + sv] = (bf16)(raw.x >> 16);
        B2[(vg * 8 + 2) * 232 + sv] = (bf16)(raw.y & 0xffff); B2[(vg * 8 + 3) * 232 + sv] = (bf16)(raw.y >> 16);
        B2[(vg * 8 + 4) * 232 + sv] = (bf16)(raw.z & 0xffff); B2[(vg * 8 + 5) * 232 + sv] = (bf16)(raw.z >> 16);
        B2[(vg * 8 + 6) * 232 + sv] = (bf16)(raw.w & 0xffff); B2[(vg * 8 + 7) * 232 + sv] = (bf16)(raw.w >> 16); }
    for (int e = tid; e < 16 * 128; e += NTHR) { const int r = e >> 7, ss = e & 127; B2[(192 + r) * 232 + ss] = (r == 0) ? (bf16)0x3f80 : (bf16)0; }
#pragma unroll
    for (int i = 0; i < 5; ++i) { const int e = tid + NTHR * i; if (e < CT_ROWS * 12) *(LAS u32x4*)(B2 + (e / 12) * 232 + 128 + (e % 12) * 8) = rct[i]; }
    MLO_LOADS(min(unit2 + G, 2047));
    __syncthreads();
    {
        const int vt0 = wh * 6;
        f32x4 oacc[7];
#pragma unroll
        for (int j = 0; j < 7; ++j) oacc[j] = (f32x4){0.f, 0.f, 0.f, 0.f};
#pragma unroll
        for (int ks = 0; ks < 7; ++ks) {
            const bf16x8 af = *(const LAS bf16x8*)(A2 + (rt * 16 + r16) * 232 + ks * 32 + g * 8);
#pragma unroll
            for (int j = 0; j < 7; ++j) { const bf16x8 bfr = *(const LAS bf16x8*)(B2 + ((vt0 + j) * 16 + r16) * 232 + ks * 32 + g * 8); oacc[j] = MFMA16(af, bfr, oacc[j]); }
        }
        if (wh == 1 && r16 == 0) {
#pragma unroll
            for (int i = 0; i < 4; ++i) sD[rt * 16 + g * 4 + i] = oacc[6][i];
        }
        u32x4 rop[3];
#pragma unroll
        for (int i = 0; i < 3; ++i) { const int e = tid + NTHR * i; rop[i] = *(const u32x4*)(P0 + (t0 + rh * 64 + e / 24) * P0W + 1536 + h * 192 + (e % 24) * 8); }
        __syncthreads();
        float hv[7][4]; float ssq[4] = {0.f, 0.f, 0.f, 0.f};
#pragma unroll
        for (int i = 0; i < 4; ++i) { const int jl = rt * 16 + g * 4 + i; const float dn = __builtin_amdgcn_rcpf(fmaxf(fabsf(sD[jl]), sE[jl]));
#pragma unroll
            for (int j = 0; j < 7; ++j) { const bool valid = (vt0 + j < 12) && !(wh == 1 && j == 0); const float x = valid ? oacc[j][i] * dn : 0.f; hv[j][i] = x; ssq[i] += x * x; } }
#pragma unroll
        for (int i = 0; i < 4; ++i) { float s = ssq[i]; s += __shfl_xor(s, 1); s += __shfl_xor(s, 2); s += __shfl_xor(s, 4); s += __shfl_xor(s, 8); if (r16 == 0) sQ[wh * 64 + rt * 16 + g * 4 + i] = s; }
        __syncthreads();
        const float* whn = inp(a, I_WHNORM) + h * 192;
#pragma unroll
        for (int j = 0; j < 7; ++j) { const int v = (vt0 + j) * 16 + r16; const bool valid = (vt0 + j < 12) && !(wh == 1 && j == 0); const float wv = whn[v < 192 ? v : 0];
#pragma unroll
            for (int i = 0; i < 4; ++i) { const int jl = rt * 16 + g * 4 + i; const float rs = rsqrtf((sQ[jl] + sQ[64 + jl]) * (1.f / 192.f) + RMS_EPS); if (valid) Yt[jl * 200 + v] = f2bf(hv[j][i] * rs * wv); } }
        __syncthreads();
        bf16* Y = (bf16*)(ws + WS_Y);
#pragma unroll
        for (int i = 0; i < 3; ++i) { const int e = tid + NTHR * i, row = e / 24, cg8 = (e % 24) * 8;
            const u32x4 yv = *(const LAS u32x4*)(Yt + row * 200 + cg8); const u32x4 op = rop[i]; u32x4 o;
#define SG2(yw, ow) pk2(__uint_as_float((yw) << 16) * __builtin_amdgcn_rcpf(1.f + __expf(-__uint_as_float((ow) << 16))), __uint_as_float((yw) & 0xffff0000u) * __builtin_amdgcn_rcpf(1.f + __expf(-__uint_as_float((ow) & 0xffff0000u))))
            o.x = SG2(yv.x, op.x); o.y = SG2(yv.y, op.y); o.z = SG2(yv.z, op.z); o.w = SG2(yv.w, op.w);
#undef SG2
            *(u32x4*)(Y + (t0 + rh * 64 + row) * D_ + h * 192 + cg8) = o; }
    }
    __syncthreads();
    }
#undef MLO_LOADS
}

typedef float f32x16 __attribute__((ext_vector_type(16)));
#define MFMA32(a, b, c) __builtin_amdgcn_mfma_f32_32x32x16_bf16((a), (b), (c), 0, 0, 0)
DI int crow32(int i, int hh) { return (i & 3) + 8 * (i >> 2) + 4 * hh; }
DI void mla_unit(const Args& a, LAS unsigned char* lds, int b, int h, int qb, int tid, int lane, int wave) {
    __attribute__((address_space(1))) unsigned char* wsg_ = (__attribute__((address_space(1))) unsigned char*)a.ws; asm volatile("" : "+s"(wsg_)); unsigned char* ws = (unsigned char*)wsg_;
    const bf16* P1 = (const bf16*)(ws + WS_BIG);
    const bf16* Qg = (const bf16*)(ws + WS_BIG + 64 * MiB);
    const bf16* KV = (const bf16*)(ws + WS_BIG + 144 * MiB);
    const size_t tb = (size_t)b * S_;
    const int n32 = lane & 31, hh = lane >> 5;
    const int q0 = qb * 512 + wave * 64;
    bf16x8 qf[2][6];
#pragma unroll
    for (int qs = 0; qs < 2; ++qs)
#pragma unroll
        for (int ks = 0; ks < 6; ++ks) qf[qs][ks] = *(const bf16x8*)(Qg + (tb + q0 + qs * 32 + n32) * QW + h * 96 + ks * 16 + hh * 8);
    f32x16 oa[2][2];
#pragma unroll
    for (int vt = 0; vt < 2; ++vt)
#pragma unroll
        for (int qs = 0; qs < 2; ++qs)
#pragma unroll
            for (int i = 0; i < 16; ++i) oa[vt][qs][i] = 0.f;
    float mrun[2] = {-INFINITY, -INFINITY}, lsum[2] = {0.f, 0.f};
    const int ntile = 4 * (qb + 1), wdiag = 8 * qb + wave;
    const int k0key = tid / 12, k0dg = tid % 12, k1key = min((tid + 512) / 12, 63), k1dg = (tid + 512) % 12;
    u32x4 rk0, rk1, rv;
#define MLA_LOAD(kt_, hf_) do { const size_t tk = tb + (size_t)(kt_) * 128 + (hf_) * 64; \
        rk0 = (k0dg < 8) ? *(const u32x4*)(KV + (tk + k0key) * KVW + h * 128 + k0dg * 8) : *(const u32x4*)(P1 + (tk + k0key) * P1W + 640 + (k0dg - 8) * 8); \
        rk1 = (k1dg < 8) ? *(const u32x4*)(KV + (tk + k1key) * KVW + h * 128 + k1dg * 8) : *(const u32x4*)(P1 + (tk + k1key) * P1W + 640 + (k1dg - 8) * 8); \
        rv = *(const u32x4*)(KV + (tk + lane) * KVW + h * 128 + 64 + wave * 8); } while (0)
#define MLA_STORE(buf_, hf_) do { LAS bf16* Kl = (LAS bf16*)(lds + (buf_) * 45568) + (hf_) * 64 * 104; LAS bf16* Vl = (LAS bf16*)(lds + (buf_) * 45568 + 26624) + (hf_) * 64; \
        *(LAS u32x4*)(Kl + k0key * 104 + k0dg * 8) = rk0; if (tid < 256) *(LAS u32x4*)(Kl + k1key * 104 + k1dg * 8) = rk1; \
        Vl[(wave * 8 + 0) * 136 + lane] = (bf16)(rv.x & 0xffff); Vl[(wave * 8 + 1) * 136 + lane] = (bf16)(rv.x >> 16); Vl[(wave * 8 + 2) * 136 + lane] = (bf16)(rv.y & 0xffff); Vl[(wave * 8 + 3) * 136 + lane] = (bf16)(rv.y >> 16); \
        Vl[(wave * 8 + 4) * 136 + lane] = (bf16)(rv.z & 0xffff); Vl[(wave * 8 + 5) * 136 + lane] = (bf16)(rv.z >> 16); Vl[(wave * 8 + 6) * 136 + lane] = (bf16)(rv.w & 0xffff); Vl[(wave * 8 + 7) * 136 + lane] = (bf16)(rv.w >> 16); } while (0)
    MLA_LOAD(0, 0); MLA_STORE(0, 0); MLA_LOAD(0, 1); MLA_STORE(0, 1);
    __syncthreads();
#pragma unroll 1
    for (int kt = 0; kt < ntile; ++kt) {
        const int buf = kt & 1;
        const bool more = kt + 1 < ntile;
        if (more) MLA_LOAD(kt + 1, 0);
        const LAS bf16* Kl = (const LAS bf16*)(lds + buf * 45568); const LAS bf16* Vl = (const LAS bf16*)(lds + buf * 45568 + 26624);
#pragma unroll
        for (int hf = 0; hf < 2; ++hf) {
#pragma unroll 1
            for (int ksub = 2 * hf; ksub < 2 * hf + 2 && 4 * kt + ksub <= 2 * wdiag + 1; ++ksub) {
                f32x16 sc[2];
#pragma unroll
                for (int qs = 0; qs < 2; ++qs)
#pragma unroll
                    for (int i = 0; i < 16; ++i) sc[qs][i] = 0.f;
                bf16x8 kf[6];
#pragma unroll
                for (int ks = 0; ks < 6; ++ks) kf[ks] = *(const LAS bf16x8*)(Kl + (ksub * 32 + n32) * 104 + ks * 16 + hh * 8);
                __builtin_amdgcn_sched_barrier(0);
                __builtin_amdgcn_s_setprio(1);
#pragma unroll
                for (int ks = 0; ks < 6; ++ks) { sc[0] = MFMA32(kf[ks], qf[0][ks], sc[0]); sc[1] = MFMA32(kf[ks], qf[1][ks], sc[1]); }
                __builtin_amdgcn_s_setprio(0);
                s16x4 vlo[2][2], vhi[2][2];
#pragma unroll
                for (int s2 = 0; s2 < 2; ++s2)
#pragma unroll
                    for (int vt = 0; vt < 2; ++vt) { const LAS bf16* vp = Vl + (vt * 32 + n32) * 136 + ksub * 32 + 16 * s2 + 4 * hh; vlo[s2][vt] = *(const LAS s16x4*)vp; vhi[s2][vt] = *(const LAS s16x4*)(vp + 8); }
                if (4 * kt + ksub >= 2 * wdiag) { const int koff = (4 * kt + ksub - 2 * wdiag) * 32;
#pragma unroll
                    for (int qs = 0; qs < 2; ++qs)
#pragma unroll
                        for (int i = 0; i < 16; ++i) if (koff + crow32(i, hh) > qs * 32 + n32) sc[qs][i] = -INFINITY;
                }
#pragma unroll
                for (int qs = 0; qs < 2; ++qs) {
                    const float t0_ = fmaxf(fmaxf(sc[qs][0], sc[qs][1]), sc[qs][2]), t1_ = fmaxf(fmaxf(sc[qs][3], sc[qs][4]), sc[qs][5]), t2_ = fmaxf(fmaxf(sc[qs][6], sc[qs][7]), sc[qs][8]);
                    const float t3_ = fmaxf(fmaxf(sc[qs][9], sc[qs][10]), sc[qs][11]), t4_ = fmaxf(fmaxf(sc[qs][12], sc[qs][13]), sc[qs][14]);
                    float tm = fmaxf(fmaxf(fmaxf(t0_, t1_), t2_), fmaxf(fmaxf(t3_, t4_), sc[qs][15]));
                    tm = xor32_max(tm);
                    const float mold = mrun[qs], mnew = fmaxf(mold, tm);
                    mrun[qs] = mnew; f32x2 ps2 = {0.f, 0.f}, ps3 = {0.f, 0.f}; const f32x2 mn2 = {mnew, mnew};
#pragma unroll
                    for (int i = 0; i < 8; ++i) { f32x2 d = {sc[qs][2 * i], sc[qs][2 * i + 1]}; d = d - mn2;
                        f32x2 p; p.x = __builtin_amdgcn_exp2f(d.x); p.y = __builtin_amdgcn_exp2f(d.y); sc[qs][2 * i] = p.x; sc[qs][2 * i + 1] = p.y; if (i & 1) ps3 = ps3 + p; else ps2 = ps2 + p; }
                    const float ps = (ps2.x + ps2.y) + (ps3.x + ps3.y);
                    if (__builtin_amdgcn_ballot_w64(mnew > mold) != 0ull) {
                        const float alpha = __builtin_amdgcn_exp2f(mold - mnew);
                        lsum[qs] *= alpha;
#pragma unroll
                        for (int vt = 0; vt < 2; ++vt) oa[vt][qs] = oa[vt][qs] * alpha;
                    }
                    lsum[qs] += ps;
                }
#pragma unroll
                for (int s2 = 0; s2 < 2; ++s2) {
                    bf16x8 pf[2];
#pragma unroll
                    for (int qs = 0; qs < 2; ++qs) { u32x4 pw; pw.x = pk2(sc[qs][8 * s2 + 0], sc[qs][8 * s2 + 1]); pw.y = pk2(sc[qs][8 * s2 + 2], sc[qs][8 * s2 + 3]);
                        pw.z = pk2(sc[qs][8 * s2 + 4], sc[qs][8 * s2 + 5]); pw.w = pk2(sc[qs][8 * s2 + 6], sc[qs][8 * s2 + 7]); pf[qs] = __builtin_bit_cast(bf16x8, pw); }
#pragma unroll
                    for (int vt = 0; vt < 2; ++vt) {
                        const bf16x8 vf = __builtin_shufflevector(vlo[s2][vt], vhi[s2][vt], 0, 1, 2, 3, 4, 5, 6, 7);
                        oa[vt][0] = MFMA32(vf, pf[0], oa[vt][0]); oa[vt][1] = MFMA32(vf, pf[1], oa[vt][1]);
                    }
                }
            }
            if (more) { MLA_STORE(buf ^ 1, hf); if (hf == 0) MLA_LOAD(kt + 1, 1); }
        }
        __syncthreads();
    }
#undef MLA_LOAD
#undef MLA_STORE
#pragma unroll
    for (int qs = 0; qs < 2; ++qs) {
        float l = xor32_sum(lsum[qs]);
        const float inv = 1.f / l;
        bf16* Y = (bf16*)(ws + WS_Y) + (tb + q0 + qs * 32 + n32) * D_ + h * 64;
#pragma unroll
        for (int vt = 0; vt < 2; ++vt)
#pragma unroll
            for (int g4 = 0; g4 < 4; ++g4) { u32x2 w; w.x = pk2(oa[vt][qs][4 * g4] * inv, oa[vt][qs][4 * g4 + 1] * inv); w.y = pk2(oa[vt][qs][4 * g4 + 2] * inv, oa[vt][qs][4 * g4 + 3] * inv);
                *(u32x2*)(Y + vt * 32 + 8 * g4 + 4 * hh) = w; }
    }
}
#define XB_TMO      128
#define XB_XCNT(j)  (256  + 64 * (j))
#define XB_XSUB(j)  (1280 + 64 * (j))
#define XB_XGEN(j)  (2304 + 64 * (j))
#define XB_TOP      3328
#define XB_TOPGEN   3392
#define XCD_BAR_WORDS 3456
#define XB_SPIN_CAP (1u << 18)

__device__ __forceinline__ unsigned xb_ld(unsigned* p)              { return __hip_atomic_load(p, __ATOMIC_RELAXED, __HIP_MEMORY_SCOPE_AGENT); }
__device__ __forceinline__ unsigned xb_add(unsigned* p, unsigned v) { return __hip_atomic_fetch_add(p, v, __ATOMIC_RELAXED, __HIP_MEMORY_SCOPE_AGENT); }
__device__ __forceinline__ unsigned xb_xcc_id() { return (unsigned)__builtin_amdgcn_s_getreg((3 << 11) | 20) & 0xFu; }
#define XB_SPIN(cond, bar) do { unsigned _sp = 0; while (cond) { __builtin_amdgcn_s_sleep(1); \
    if ((++_sp & 255u) == 0u) { if (xb_ld(&(bar)[XB_TMO])) break; if (_sp > XB_SPIN_CAP) { atomicAdd(&(bar)[XB_TMO], 1u); break; } } } } while (0)

struct XcdBarrier {
    unsigned* bar; unsigned x;
    volatile LAS unsigned* st;
};

__device__ __forceinline__ XcdBarrier xcd_barrier_post(unsigned* bar, volatile LAS unsigned* st) {
    XcdBarrier b; b.bar = bar; b.x = xb_xcc_id(); b.st = st;
    if (threadIdx.x == 0) (void)xb_add(&bar[XB_XCNT(b.x)], 1u);
    return b;
}
__device__ __forceinline__ void xcd_barrier_complete(unsigned* bar, unsigned x, unsigned& nloc, unsigned& nx) {
    const unsigned G = gridDim.x * gridDim.y * gridDim.z;
    unsigned sum, cnt, mine, sp = 0u;
    for (;;) {
        sum = 0u; cnt = 0u; mine = 0u;
#pragma unroll
        for (unsigned j = 0; j < 16; ++j) { const unsigned c = xb_ld(&bar[XB_XCNT(j)]); sum += c; cnt += (c > 0u) ? 1u : 0u; mine = (j == x) ? c : mine; }
        if (sum == G) break;
        __builtin_amdgcn_s_sleep(1);
        if ((++sp & 255u) == 0u) { if (xb_ld(&bar[XB_TMO])) break; if (sp > XB_SPIN_CAP) { atomicAdd(&bar[XB_TMO], 1u); break; } }
    }
    nloc = mine > 0u ? mine : 1u; nx = cnt > 0u ? cnt : 1u;
}

__device__ __forceinline__ void xcd_barrier(const XcdBarrier& b) {
    asm volatile("s_waitcnt vmcnt(0)" ::: "memory");
    __syncthreads();
    if (threadIdx.x == 0) {
        unsigned* bar = b.bar;
        __builtin_amdgcn_s_waitcnt(0);
        unsigned nloc = b.st[0], nx = b.st[1];
        if (nloc == 0u) { xcd_barrier_complete(bar, b.x, nloc, nx); b.st[0] = nloc; b.st[1] = nx; }
        const unsigned old = xb_add(&bar[XB_XSUB(b.x)], 1u);
        const unsigned gen = old / nloc;
        if (old + 1u == (gen + 1u) * nloc) {
            __builtin_amdgcn_fence(__ATOMIC_RELEASE, "agent");
            asm volatile("s_waitcnt vmcnt(0)" ::: "memory");
            const unsigned og = xb_add(&bar[XB_TOP], 1u);
            const unsigned tg = og / nx;
            if (og + 1u == (tg + 1u) * nx) xb_add(&bar[XB_TOPGEN], 1u);
            else XB_SPIN(xb_ld(&bar[XB_TOPGEN]) == tg, bar);
            __builtin_amdgcn_fence(__ATOMIC_ACQUIRE, "agent");
            xb_add(&bar[XB_XGEN(b.x)], 1u);
            asm volatile("s_waitcnt vmcnt(0)" ::: "memory");
        } else {
            XB_SPIN(xb_ld(&bar[XB_XGEN(b.x)]) == gen, bar);
            __builtin_amdgcn_fence(__ATOMIC_ACQUIRE, "agent");
            asm volatile("s_waitcnt vmcnt(0)" ::: "memory");
        }
    }
    __syncthreads();
}

constexpr size_t WS_BAR = 7 * 131072 + 65536;
constexpr int LDS_BARST = LDS_BYTES - 64;
constexpr int NPHASE = 15;
static_assert(pg8::EP_CS == WS_CS && pg8::EP_MEMKV == WS_MEMKV && pg8::EP_XB == WS_XB && pg8::EP_BIG == WS_BIG && pg8::EP_T == T_ && WS_ROWSQ == 0, "epilogue constants");
__global__ void __launch_bounds__(NTHR, 2) fwd_mega(Args a) {
    extern __shared__ __attribute__((aligned(16))) unsigned char lds_raw[];
    LAS unsigned char* lds = (LAS unsigned char*)lds_raw;
    cg::grid_group grid = cg::this_grid();
    const int G = gridDim.x, bx = blockIdx.x;
#define TIDS int tid = threadIdx.x; asm volatile("" : "+v"(tid)); const int lane = tid & 63, wave = __builtin_amdgcn_readfirstlane(tid >> 6); int G_ = G; asm volatile("" : "+s"(G_)); const int gw = bx * NWAVES + wave, gt = bx * NTHR + tid, NGW = G_ * NWAVES, NGT = G_ * NTHR; (void)gw; (void)gt; (void)lane; (void)NGW; (void)NGT;
    for (int ph = a.ph_lo; ph < a.ph_hi; ++ph) {
        __attribute__((address_space(1))) unsigned char* wsg_ = (__attribute__((address_space(1))) unsigned char*)a.ws; asm volatile("" : "+s"(wsg_)); unsigned char* ws = (unsigned char*)wsg_;
        float* rowsq = (float*)(ws + WS_ROWSQ); (void)rowsq;
        bf16* XB = (bf16*)(ws + WS_XB); bf16* Yb = (bf16*)(ws + WS_Y); bf16* Hb = (bf16*)(ws + WS_BIG);
        bf16* P0 = (bf16*)(ws + WS_BIG); bf16* P1 = (bf16*)(ws + WS_BIG); bf16* Qb = (bf16*)(ws + WS_BIG + 64 * MiB); bf16* KVb = (bf16*)(ws + WS_BIG + 144 * MiB);
        const float* cs = (const float*)(ws + WS_CS);
        {
        int j0 = 0, j1 = 0;
        if (ph == 1) { j0 = 0; j1 = 2; } else if (ph == 5) { j0 = 2; j1 = 3; } else if (ph == 6) { j0 = 3; j1 = 4; } else if (ph == 7) { j0 = 4; j1 = 5; } else if (ph == 8) { j0 = 5; j1 = 6; }
        else if (ph == 9) { j0 = 6; j1 = 8; } else if (ph == 11) { j0 = 8; j1 = 9; } else if (ph == 12) { j0 = 9; j1 = 10; } else if (ph == 13) { j0 = 10; j1 = 11; }
        for (int job = j0; job < j1; ++job) {
            pg8::Gemm g; pg8::Epi e{job, ws, a};
            g.M = T_; g.lda = 1024; g.K = 1024; g.N = 1024; g.A = XB; g.Bt = nullptr;
            switch (job) {
                case 0: g.Bt = (const bf16*)(ws + WS_WIN0); g.N = P0W; break;
                case 1: g.A = (const bf16*)(ws + WS_MEMBF); g.Bt = (const bf16*)(ws + WS_WMEM); g.M = TM_; g.N = 512; break;
                case 2: g.A = Yb; g.Bt = (const bf16*)(ws + WS_WOUT0); break;
                case 3: g.Bt = (const bf16*)(ws + WS_WFF1_0); g.N = FF_; break;
                case 4: g.A = Hb; g.lda = FF_; g.K = FF_; g.Bt = (const bf16*)(ws + WS_WFF2_0); break;
                case 5: g.Bt = (const bf16*)(ws + WS_WIN1); break;
                case 6: g.A = P1 + 256; g.K = 384; g.Bt = (const bf16*)(ws + WS_WUQ); g.N = QW; break;
                case 7: g.A = P1; g.K = 256; g.Bt = (const bf16*)(ws + WS_WUKV); g.N = KVW; break;
                case 8: g.A = Yb; g.Bt = (const bf16*)(ws + WS_WOUT1); break;
                case 9: g.Bt = (const bf16*)(ws + WS_WFF1_1); g.N = FF_; break;
                default: g.A = Hb; g.lda = FF_; g.K = FF_; g.Bt = (const bf16*)(ws + WS_WFF2_1); break;
            }
            pg8::StaticOrder S; S.init(g.M, g.N, G, bx);
            pg8::gemm_phase<pg8::Epi, pg8::StaticOrder, true, true>(lds, g, S, e);
            __syncthreads();
        }
        if (ph == 0) { TIDS; p0_prologue(a, lds, gw, NGW, lane, wave, tid); }
        else if (ph == 2) { TIDS;
            for (int u = bx; u < 1024; u += G) mlstm_local_unit(a, lds, u, tid, lane, wave);
            for (int u = bx; u < 256; u += G) memattn_unit(a, lds, P0, P0W, 2304, u, tid, lane, wave);
        }
        else if (ph == 3) { TIDS; mlstm_scan(a, gt, NGT); }
        else if (ph == 4) { TIDS; mlstm_out_phase(a, lds, bx, G, tid); }
        else if (ph == 10) { TIDS;
            for (int r = 0; r * G < 768; ++r) { const int i = (G == 256 && r == 1) ? 511 - bx : r * G + bx; if (i < 768) { const int qb = 7 - i / 96, bh = i % 96; mla_unit(a, lds, bh / 12, bh % 12, qb, tid, lane, wave); } }
            for (int u = bx; u < 256; u += G) memattn_unit(a, lds, P1, P1W, 768, u, tid, lane, wave);
        }
        else if (ph == 14) { TIDS;
            const float* fg = inp(a, I_FINALNORM);
            for (int m0 = gw; m0 < T_; m0 += 4 * NGW) {
                f32x4 xv[4][4]; float rs[4];
                const f32x4 gv0 = ((const f32x4*)fg)[lane], gv1 = ((const f32x4*)fg)[64 + lane], gv2 = ((const f32x4*)fg)[128 + lane], gv3 = ((const f32x4*)fg)[192 + lane];
#pragma unroll
                for (int rr = 0; rr < 4; ++rr) { const int m = min(m0 + rr * NGW, T_ - 1); const f32x4* xr = (const f32x4*)(a.out + (size_t)m * D_) + lane; rs[rr] = rsqrtf(rowsq[4 * T_ + m] * (1.f / D_) + RMS_EPS);
#pragma unroll
                    for (int j = 0; j < 4; ++j) xv[rr][j] = xr[64 * j]; }
#pragma unroll
                for (int rr = 0; rr < 4; ++rr) { const int m = m0 + rr * NGW; if (m < T_) { f32x4* xw = (f32x4*)(a.out + (size_t)m * D_) + lane;
                        xw[0] = xv[rr][0] * rs[rr] * gv0; xw[64] = xv[rr][1] * rs[rr] * gv1; xw[128] = xv[rr][2] * rs[rr] * gv2; xw[192] = xv[rr][3] * rs[rr] * gv3; } }
            }
        }
        }
        if (ph + 1 < a.ph_hi) {
            if (a.ph_hi < 0) grid.sync();
            if (ph == a.ph_lo && threadIdx.x == 0) {
                volatile LAS unsigned* st_ = (volatile LAS unsigned*)(lds + LDS_BARST); st_[0] = 0u; st_[1] = 0u; (void)xb_add((unsigned*)(a.ws + WS_BAR) + XB_XCNT(xb_xcc_id()), 1u); }
            { XcdBarrier xb_; xb_.bar = (unsigned*)(a.ws + WS_BAR); xb_.x = xb_xcc_id(); xb_.st = (volatile LAS unsigned*)(lds + LDS_BARST); xcd_barrier(xb_); }
        }
    }
}

extern "C" void kernel_launch(void* const* d_in, const int* in_sizes, int n_in, void* d_out, int out_size, void* d_ws, size_t ws_size, hipStream_t stream) {
    static int grid = 0;
    if (grid == 0) {
        if (n_in != 26 || ws_size < WS_END || out_size != T_ * D_) { fprintf(stderr, "kernel_launch: unexpected problem (n_in %d, ws %zu, out %d)\n", n_in, ws_size, out_size); grid = -1; return; }
        int dev = 0, cus = 0, per_cu = 0;
        (void)hipGetDevice(&dev); (void)hipDeviceGetAttribute(&cus, hipDeviceAttributeMultiprocessorCount, dev);
        if (hipFuncSetAttribute((const void*)fwd_mega, hipFuncAttributeMaxDynamicSharedMemorySize, LDS_BYTES) != hipSuccess) { fprintf(stderr, "kernel_launch: hipFuncSetAttribute failed\n"); grid = -1; return; }
        if (hipOccupancyMaxActiveBlocksPerMultiprocessor(&per_cu, (const void*)fwd_mega, NTHR, LDS_BYTES) != hipSuccess || per_cu < 1) { fprintf(stderr, "kernel_launch: occupancy query gave %d\n", per_cu); per_cu = 1; }
        (void)hipGetLastError();
        grid = cus * per_cu;
        fprintf(stderr, "kernel_launch: grid %d (cus %d x %d)\n", grid, cus, per_cu);
    }
    if (grid < 0) return;
    if (!MK_MULTI) (void)hipMemsetAsync((unsigned char*)d_ws + WS_BAR, 0, 16384, stream);
    Args a{};
    for (int i = 0; i < 26; ++i) a.in[i] = (const float*)d_in[i];
    a.out = (float*)d_out; a.ws = (unsigned char*)d_ws;
#if MK_MULTI
    for (int ph = 0; ph < NPHASE; ++ph) { a.ph_lo = ph; a.ph_hi = ph + 1; hipLaunchKernelGGL(fwd_mega, dim3(grid), dim3(NTHR), LDS_BYTES, stream, a); }
#else
    a.ph_lo = 0; a.ph_hi = NPHASE;
    void* args[] = {&a};
    hipError_t e = hipLaunchCooperativeKernel((const void*)fwd_mega, dim3(grid), dim3(NTHR), args, LDS_BYTES, stream);
    if (e != hipSuccess) fprintf(stderr, "kernel_launch: cooperative launch failed: %s (grid %d)\n", hipGetErrorString(e), grid);
#endif
}
```

```cpp
#include <hip/hip_runtime.h>
#include <hip/hip_cooperative_groups.h>
#include <cstdio>
#include <cstdint>
namespace cg = cooperative_groups;
constexpr float RMS_EPS = 1e-6f;
#ifndef MK_MULTI
#define MK_MULTI 0
#endif
#ifndef PROBE_MASK
#define PROBE_MASK 0
#endif
struct KArgs { const float* in[26]; float* out; unsigned char* ws; int ph_lo, ph_hi; };
namespace pg8 {
#define PG8_LAS __attribute__((address_space(3)))
typedef unsigned short bf16_t;
typedef short bf16x8 __attribute__((ext_vector_type(8)));
typedef float f32x4 __attribute__((ext_vector_type(4)));
typedef unsigned u32x4 __attribute__((ext_vector_type(4)));
constexpr int BM = 256, BK = 64, HALF = 128, HTB = HALF * BK * 2  , STAGE_BYTES = 8 * HTB, NXCD = 8, WGM = 8;

__host__ __device__ __forceinline__ int lds_byte(int r, int c) { const int st = (r >> 4) * 2 + (c >> 5), rr = r & 15, cc = c & 31, ob = rr * 64 + cc * 2; return st * 1024 + (ob ^ (((ob >> 9) & 1) << 5)); }
__host__ __device__ __forceinline__ void stage_rc(int b, int& R, int& C) { const int st = b / 1024, sb = b % 1024, swz = sb ^ (((sb >> 9) & 1) << 5); R = (st >> 1) * 16 + swz / 64; C = (st & 1) * 32 + (swz % 64) / 2; }
__host__ __device__ __forceinline__ int perm32(int rho) { const int n = rho >> 4, i = rho & 15; return 8 * (i >> 2) + 4 * n + (i & 3); }

struct Unit { int pm, pn; };
struct Gemm { const bf16_t* A; const bf16_t* Bt; int M, N, K, lda; };

struct StaticOrder {
    int nM, nN, nwg, G, c, inv;
    __host__ __device__ void init(int M, int N, int G_, int c_) { nM = M / BM; nN = N / BM; nwg = nM * nN; G = G_; c = c_; inv = ((1 << 20) + WGM * nN - 1) / (WGM * nN); }
    __host__ __device__ bool next(int i, Unit& u) const {
        const long L = (long)i * G + c; if (L >= nwg) return false;
        int wgid = (int)L; { const int q = nwg / NXCD, r = nwg % NXCD, xcd = wgid % NXCD, off = wgid / NXCD; wgid = (xcd < r ? xcd * (q + 1) : r * (q + 1) + (xcd - r) * q) + off; }
        const int nig = WGM * nN, gid = (int)(((unsigned)wgid * (unsigned)inv) >> 20), rem = wgid - gid * nig, fm = gid * WGM, gsz = (nM - fm) < WGM ? (nM - fm) : WGM;
        if (gsz == WGM) { u.pm = fm + (rem & (WGM - 1)); u.pn = rem >> 3; }
        else { u.pm = fm + (rem % gsz); u.pn = rem / gsz; }
        return true;
    }
    __device__ __forceinline__ void a_ready(const Unit&) const {}
    __device__ __forceinline__ void done(const Unit&) const {}
};

__device__ __forceinline__ unsigned cvt_pk_bf16(float lo, float hi) { unsigned r; asm volatile("v_cvt_pk_bf16_f32 %0, %1, %2" : "=v"(r) : "v"(lo), "v"(hi)); return r; }

constexpr size_t EP_CS = 2u << 20, EP_MEMKV = 8u << 20, EP_XB = 64u << 20, EP_BIG = 232u << 20; constexpr int EP_T = 32768;
struct Epi {
    static constexpr bool PERM = true, AFTER_DRAIN = false;
    int job; unsigned char* ws; const KArgs& ka;
    template <int MODE> __device__ __forceinline__ void body(const f32x4 (&acc)[2][2][4][2], const Unit& u, int wr, int wc, int fr, int fq,
            int ldc, bf16_t* O, const float* rowsq, float inv_n, float oscale, float* sqA, float* sqB, const float* cs, const float* xold, float* xnew) const {
        const int row0 = u.pm * BM + wr * 64 + fr, col0 = u.pn * BM + wc * 32 + 8 * fq;
        float rsv[8];
#pragma unroll
        for (int r8 = 0; r8 < 8; ++r8) rsv[r8] = (MODE != 3) ? rowsq[row0 + (r8 >> 2) * HALF + (r8 & 3) * 16] : 0.f;
        f32x4 xn[2][2];
        if (MODE == 3) {
#pragma unroll
            for (int bj = 0; bj < 2; ++bj) { const float* xp = xold + (size_t)row0 * ldc + col0 + bj * HALF; xn[bj][0] = *(const f32x4*)xp; xn[bj][1] = *(const f32x4*)(xp + 4); }
        }
#pragma unroll
        for (int ai = 0; ai < 2; ++ai)
#pragma unroll
            for (int m = 0; m < 4; ++m) {
                const int row = row0 + ai * HALF + m * 16;
                float rs = 1.f;
                if (MODE != 3) rs = rsqrtf(rsv[ai * 4 + m] * inv_n + RMS_EPS) * oscale;
                f32x4 xc[2][2];
                if (MODE == 3) {
#pragma unroll
                    for (int bj = 0; bj < 2; ++bj) { xc[bj][0] = xn[bj][0]; xc[bj][1] = xn[bj][1]; }
                    if (ai * 4 + m < 7) { const int rown = row0 + ((ai * 4 + m + 1) >> 2) * HALF + ((ai * 4 + m + 1) & 3) * 16;
#pragma unroll
                        for (int bj = 0; bj < 2; ++bj) { const float* xp = xold + (size_t)rown * ldc + col0 + bj * HALF; xn[bj][0] = *(const f32x4*)xp; xn[bj][1] = *(const f32x4*)(xp + 4); } }
                }
                float ss[2];
#pragma unroll
                for (int bj = 0; bj < 2; ++bj) {
                    const int col = col0 + bj * HALF;
                    f32x4 v0 = acc[ai][bj][m][0] * rs, v1 = acc[ai][bj][m][1] * rs;
                    if (MODE == 3) {
                        v0 = v0 + xc[bj][0]; v1 = v1 + xc[bj][1];
                        *(f32x4*)(xnew + (size_t)row * ldc + col) = v0; *(f32x4*)(xnew + (size_t)row * ldc + col + 4) = v1;
                    }
                    if (MODE == 4) {
#pragma unroll
                        for (int e = 0; e < 4; ++e) { const float a = fmaxf(v0[e], 0.f), b = fmaxf(v1[e], 0.f); v0[e] = a * a; v1[e] = b * b; }
                    }
                    ss[bj] = (v0[0] * v0[0] + v0[1] * v0[1]) + (v0[2] * v0[2] + v0[3] * v0[3]) + (v1[0] * v1[0] + v1[1] * v1[1]) + (v1[2] * v1[2] + v1[3] * v1[3]);
                    bool rope = false; int p = 0;
                    if (MODE == 1) { rope = (u.pn == 2 && bj == 1 && wc == 0); p = 4 * fq; }
                    if (MODE == 2) { const int j = col % 96; rope = (j >= 64) && (col < 1152); p = (j - 64) >> 1; }
                    if (rope) {
                        const f32x4 c0 = *(const f32x4*)(cs + (size_t)row * 32 + 2 * p), c1 = *(const f32x4*)(cs + (size_t)row * 32 + 2 * p + 4);
                        f32x4 r0, r1;
                        r0[0] = v0[0] * c0[0] - v0[1] * c0[1]; r0[1] = v0[1] * c0[0] + v0[0] * c0[1];
                        r0[2] = v0[2] * c0[2] - v0[3] * c0[3]; r0[3] = v0[3] * c0[2] + v0[2] * c0[3];
                        r1[0] = v1[0] * c1[0] - v1[1] * c1[1]; r1[1] = v1[1] * c1[0] + v1[0] * c1[1];
                        r1[2] = v1[2] * c1[2] - v1[3] * c1[3]; r1[3] = v1[3] * c1[2] + v1[2] * c1[3];
                        v0 = r0; v1 = r1;
                    }
                    u32x4 w; w.x = cvt_pk_bf16(v0[0], v0[1]); w.y = cvt_pk_bf16(v0[2], v0[3]); w.z = cvt_pk_bf16(v1[0], v1[1]); w.w = cvt_pk_bf16(v1[2], v1[3]);
                    if (job != 10) *(u32x4*)(O + (size_t)row * ldc + col) = w;
                }
                if (MODE == 1 || MODE == 3) {
                    float s0 = ss[0], s1 = ss[1];
                    s0 += __shfl_xor(s0, 16); s0 += __shfl_xor(s0, 32); s1 += __shfl_xor(s1, 16); s1 += __shfl_xor(s1, 32);
                    if (fq == 0) {
                        if (MODE == 3) unsafeAtomicAdd(sqA + row, s0 + s1);
                        else { if (u.pn == 0) unsafeAtomicAdd(sqA + row, s0 + s1); else if (u.pn == 1) unsafeAtomicAdd(sqB + row, s0 + s1); else if (u.pn == 2) unsafeAtomicAdd(sqB + row, s0); }
                    }
                }
            }
    }
    __device__ __forceinline__ void operator()(const f32x4 (&acc)[2][2][4][2], const Unit& u, int wr, int wc, int fr, int fq) const {
        float* rsq = (float*)ws; const float* cs = (const float*)(ws + EP_CS); float* xo = ka.out;
        bf16_t* OB = (bf16_t*)(ws + EP_BIG); bf16_t* OX = (bf16_t*)(ws + EP_XB);
        const float kq = 0.10206207261596575f * 1.4426950408889634f;
#define EPI_CALL(MODE_, LDC_, O_, RSQ_, INVN_, OSC_, SQA_, SQB_, XOLD_) body<MODE_>(acc, u, wr, wc, fr, fq, LDC_, O_, RSQ_, INVN_, OSC_, SQA_, SQB_, cs, XOLD_, xo)
        switch (job) {
            case 0: EPI_CALL(0, 2560, OB, rsq, 1.f / 1024.f, 1.f, nullptr, nullptr, xo); break;
            case 1: EPI_CALL(0, 512, (bf16_t*)(ws + EP_MEMKV), rsq + 7 * EP_T, 1.f / 1024.f, 1.f, nullptr, nullptr, xo); break;
            case 2: EPI_CALL(3, 1024, OX, rsq, 1.f / 1024.f, 1.f, rsq + 1 * EP_T, nullptr, ka.in[0]); break;
            case 3: EPI_CALL(4, 4096, OB, rsq + 1 * EP_T, 1.f / 1024.f, 1.f, nullptr, nullptr, xo); break;
            case 4: EPI_CALL(3, 1024, OX, rsq, 1.f / 1024.f, 1.f, rsq + 2 * EP_T, nullptr, xo); break;
            case 5: EPI_CALL(1, 1024, OB, rsq + 2 * EP_T, 1.f / 1024.f, 1.f, rsq + 6 * EP_T, rsq + 5 * EP_T, xo); break;
            case 6: EPI_CALL(2, 1280, OB + (32u << 20), rsq + 5 * EP_T, 1.f / 384.f, kq, nullptr, nullptr, xo); break;
            case 7: EPI_CALL(0, 1536, OB + (72u << 20), rsq + 6 * EP_T, 1.f / 256.f, 1.f, nullptr, nullptr, xo); break;
            case 8: EPI_CALL(3, 1024, OX, rsq, 1.f / 1024.f, 1.f, rsq + 3 * EP_T, nullptr, xo); break;
            case 9: EPI_CALL(4, 4096, OB, rsq + 3 * EP_T, 1.f / 1024.f, 1.f, nullptr, nullptr, xo); break;
            default: EPI_CALL(3, 1024, OX, rsq, 1.f / 1024.f, 1.f, rsq + 4 * EP_T, nullptr, xo); break;
        }
#undef EPI_CALL
    }
};
template <class Epi, class Sched, bool ALIGN_EPI = false, bool SP2 = false>
__device__ __forceinline__ void gemm_phase(PG8_LAS unsigned char* lds, const Gemm g, const Sched& S, const Epi& E) {
    int tid_ = threadIdx.x; asm volatile("" : "+v"(tid_));
    const int tid = tid_, wid = __builtin_amdgcn_readfirstlane(tid >> 6), lane = tid & 63, wr = wid >> 2, wc = wid & 3, fr = lane & 15, fq = lane >> 4;
    const int K = g.K, nt = K / BK;
    unsigned voffA[2], voffB[2];
#pragma unroll
    for (int i = 0; i < 2; ++i) { int R, C; stage_rc(tid * 16 + i * 8192, R, C); const int Rb = Epi::PERM ? ((R & ~31) + perm32(R & 31)) : R;
        voffA[i] = (unsigned)(R * g.lda + C) * 2u; voffB[i] = (unsigned)(Rb * K + C) * 2u; }
    const size_t kstep = (size_t)(BK * 2);
    const size_t hstepB = (size_t)HALF * K * 2, hstepA = (size_t)HALF * g.lda * 2;
    const size_t tstepB = 2 * hstepB, tstepA = 2 * hstepA;
    const unsigned ldsw = (unsigned)wid * 1024u;
    const int aoff = lds_byte(wr * 64 + fr, fq * 8), boff = lds_byte(wc * 32 + fr, fq * 8);
#define PG8_SA(b, h) (((b) * 2 + (h)) * HTB)
#define PG8_SB(b, h) ((4 + (b) * 2 + (h)) * HTB)
#define PG8_STAGE(bufoff, gbase, voff) do { _Pragma("unroll") for (int _i = 0; _i < 2; ++_i) \
        __builtin_amdgcn_global_load_lds((const unsigned*)((const char*)(gbase) + (voff)[_i]), (PG8_LAS unsigned*)(lds + (bufoff) + ldsw + _i * 8192), 16, 0, 0); } while (0)
#define PG8_LDA(dst, b, h) do { _Pragma("unroll") for (int m = 0; m < 4; ++m) _Pragma("unroll") for (int k = 0; k < 2; ++k) dst[m][k] = *(const PG8_LAS bf16x8*)(lds + PG8_SA(b, h) + aoff + m * 2048 + k * 1024); } while (0)
#define PG8_LDB(dst, b, h) do { _Pragma("unroll") for (int n = 0; n < 2; ++n) _Pragma("unroll") for (int k = 0; k < 2; ++k) dst[n][k] = *(const PG8_LAS bf16x8*)(lds + PG8_SB(b, h) + boff + n * 2048 + k * 1024); } while (0)
#define PG8_MMA(ai, bj, At, Bt) do { __builtin_amdgcn_s_setprio(1); _Pragma("unroll") for (int m = 0; m < 4; ++m) _Pragma("unroll") for (int n = 0; n < 2; ++n) _Pragma("unroll") for (int k = 0; k < 2; ++k) \
        acc[ai][bj][m][n] = __builtin_amdgcn_mfma_f32_16x16x32_bf16(Bt[n][k], At[m][k], acc[ai][bj][m][n], 0, 0, 0); __builtin_amdgcn_s_setprio(0); } while (0)
#define PG8_WAIT_V(n) asm volatile("s_waitcnt vmcnt(" #n ")" ::: "memory")
#define PG8_WAIT_L(n) asm volatile("s_waitcnt lgkmcnt(" #n ")" ::: "memory")
#define PG8_BAR __builtin_amdgcn_s_barrier()
#define PG8_SCHED __builtin_amdgcn_sched_barrier(0)
    Unit cur, nxt; int ui = 0;
    if (!S.next(0, cur)) return;
    f32x4 acc[2][2][4][2];
#pragma unroll
    for (int a = 0; a < 2; ++a)
#pragma unroll
        for (int b = 0; b < 2; ++b)
#pragma unroll
            for (int m = 0; m < 4; ++m)
#pragma unroll
                for (int n = 0; n < 2; ++n) acc[a][b][m][n] = (f32x4){0.f, 0.f, 0.f, 0.f};
    bf16x8 At[4][2], B0[2][2], B1[2][2];
    const char* cA = (const char*)g.A + (size_t)cur.pm * tstepA; const char* cB = (const char*)g.Bt + (size_t)cur.pn * tstepB;
    S.a_ready(cur);
    if constexpr (SP2) {
        PG8_STAGE(PG8_SB(0, 0), cB, voffB); PG8_STAGE(PG8_SB(0, 1), cB + hstepB, voffB); PG8_STAGE(PG8_SA(0, 0), cA, voffA); PG8_STAGE(PG8_SA(0, 1), cA + hstepA, voffA);
        if (wr == 1) PG8_BAR;
        PG8_WAIT_V(2); PG8_BAR;
        PG8_STAGE(PG8_SB(1, 0), cB + kstep, voffB); PG8_STAGE(PG8_SA(1, 0), cA + kstep, voffA); PG8_STAGE(PG8_SB(1, 1), cB + hstepB + kstep, voffB);
        PG8_WAIT_V(6); PG8_BAR;
    } else {
        PG8_STAGE(PG8_SB(0, 0), cB, voffB); PG8_STAGE(PG8_SA(0, 0), cA, voffA); PG8_STAGE(PG8_SB(0, 1), cB + hstepB, voffB); PG8_STAGE(PG8_SA(0, 1), cA + hstepA, voffA);
        if (wr == 1) PG8_BAR;
        PG8_WAIT_V(4); PG8_BAR;
        PG8_STAGE(PG8_SB(1, 0), cB + kstep, voffB); PG8_STAGE(PG8_SA(1, 0), cA + kstep, voffA); PG8_STAGE(PG8_SB(1, 1), cB + hstepB + kstep, voffB);
        PG8_WAIT_V(6); PG8_BAR;
    }
    for (;;) {
        const bool has_next = S.next(ui + 1, nxt);
        const char* nA = has_next ? (const char*)g.A + (size_t)nxt.pm * tstepA : cA; const char* nB = has_next ? (const char*)g.Bt + (size_t)nxt.pn * tstepB : cB;
        for (int t = 0; t < nt; t += 2) {
            const bool last = (t == nt - 2);
            const char* a1 = cA + (size_t)(t + 1) * kstep;
            const char* a2 = last ? nA : cA + (size_t)(t + 2) * kstep; const char* b2 = last ? nB : cB + (size_t)(t + 2) * kstep;
            const char* a3 = a2 + kstep; const char* b3 = b2 + kstep;
            if (last && has_next) S.a_ready(nxt);
            if constexpr (SP2) {
            PG8_LDB(B0, 0, 0); PG8_LDB(B1, 0, 1); PG8_SCHED; PG8_LDA(At, 0, 0); PG8_STAGE(PG8_SA(1, 1), a1 + hstepA, voffA);
            PG8_WAIT_V(8); PG8_WAIT_L(0); PG8_BAR; PG8_MMA(0, 0, At, B0); PG8_MMA(0, 1, At, B1); PG8_BAR; PG8_SCHED;
            PG8_LDA(At, 0, 1); PG8_STAGE(PG8_SB(0, 0), b2, voffB); PG8_STAGE(PG8_SB(0, 1), b2 + hstepB, voffB); PG8_STAGE(PG8_SA(0, 0), a2, voffA);
            PG8_WAIT_V(8); PG8_WAIT_L(0); PG8_BAR; PG8_MMA(1, 0, At, B0); PG8_MMA(1, 1, At, B1); PG8_BAR; PG8_SCHED;
            PG8_LDB(B0, 1, 0); PG8_LDB(B1, 1, 1); PG8_SCHED; PG8_LDA(At, 1, 0); PG8_STAGE(PG8_SA(0, 1), a2 + hstepA, voffA);
            PG8_WAIT_V(8); PG8_WAIT_L(0); PG8_BAR; PG8_MMA(0, 0, At, B0); PG8_MMA(0, 1, At, B1); PG8_BAR; PG8_SCHED;
            PG8_LDA(At, 1, 1); PG8_STAGE(PG8_SB(1, 0), b3, voffB); PG8_STAGE(PG8_SB(1, 1), b3 + hstepB, voffB); PG8_STAGE(PG8_SA(1, 0), a3, voffA);
            PG8_WAIT_V(8); PG8_WAIT_L(0); PG8_BAR; PG8_MMA(1, 0, At, B0); PG8_MMA(1, 1, At, B1); PG8_BAR; PG8_SCHED;
            } else {
            PG8_LDB(B0, 0, 0); PG8_SCHED; PG8_LDA(At, 0, 0); PG8_STAGE(PG8_SA(1, 1), a1 + hstepA, voffA);
            PG8_WAIT_L(8); PG8_BAR; PG8_WAIT_L(0); PG8_MMA(0, 0, At, B0); PG8_BAR; PG8_SCHED;
            PG8_LDB(B1, 0, 1); PG8_STAGE(PG8_SB(0, 0), b2, voffB);
            PG8_BAR; PG8_WAIT_L(0); PG8_MMA(0, 1, At, B1); PG8_BAR;
            PG8_LDA(At, 0, 1); PG8_STAGE(PG8_SA(0, 0), a2, voffA);
            PG8_BAR; PG8_WAIT_L(0); PG8_MMA(1, 0, At, B0); PG8_BAR; PG8_SCHED;
            PG8_STAGE(PG8_SB(0, 1), b2 + hstepB, voffB);
            PG8_WAIT_V(6); PG8_BAR; PG8_MMA(1, 1, At, B1); PG8_BAR;
            PG8_LDB(B0, 1, 0); PG8_SCHED; PG8_LDA(At, 1, 0); PG8_STAGE(PG8_SA(0, 1), a2 + hstepA, voffA);
            PG8_WAIT_L(8); PG8_BAR; PG8_WAIT_L(0); PG8_MMA(0, 0, At, B0); PG8_BAR; PG8_SCHED;
            PG8_LDB(B1, 1, 1); PG8_STAGE(PG8_SB(1, 0), b3, voffB);
            PG8_BAR; PG8_WAIT_L(0); PG8_MMA(0, 1, At, B1); PG8_BAR;
            PG8_LDA(At, 1, 1); PG8_STAGE(PG8_SA(1, 0), a3, voffA);
            PG8_BAR; PG8_WAIT_L(0); PG8_MMA(1, 0, At, B0); PG8_BAR; PG8_SCHED;
            PG8_STAGE(PG8_SB(1, 1), b3 + hstepB, voffB);
            PG8_WAIT_V(6); PG8_BAR; PG8_MMA(1, 1, At, B1); PG8_BAR;
            }
        }
        if constexpr (ALIGN_EPI) { if (wr == 0) PG8_BAR; }
        if constexpr (!Epi::AFTER_DRAIN) { E(acc, cur, wr, wc, fr, fq); S.done(cur); }
        if (!has_next) break;
#pragma unroll
        for (int a = 0; a < 2; ++a)
#pragma unroll
            for (int b = 0; b < 2; ++b)
#pragma unroll
                for (int m = 0; m < 4; ++m)
#pragma unroll
                    for (int n = 0; n < 2; ++n) acc[a][b][m][n] = (f32x4){0.f, 0.f, 0.f, 0.f};
        cur = nxt; cA = nA; cB = nB; ++ui;
        if constexpr (ALIGN_EPI) { if (wr == 1) PG8_BAR; }
    }
    PG8_WAIT_V(0);
    if constexpr (!ALIGN_EPI) { if (wr == 0) PG8_BAR; }
    PG8_BAR;
    if constexpr (Epi::AFTER_DRAIN) { E.fused(acc, cur, wr, wc, fr, fq, lds, wid, lane); S.done(cur); }
#undef PG8_SA
#undef PG8_SB
#undef PG8_STAGE
#undef PG8_LDA
#undef PG8_LDB
#undef PG8_MMA
#undef PG8_WAIT_V
#undef PG8_WAIT_L
#undef PG8_BAR
#undef PG8_SCHED
}
}
#define LAS __attribute__((address_space(3)))
#define DI __device__ __forceinline__
typedef unsigned short bf16;
typedef short bf16x8 __attribute__((ext_vector_type(8)));
typedef short s16x4 __attribute__((ext_vector_type(4)));
typedef float f32x4 __attribute__((ext_vector_type(4)));
typedef unsigned u32x4 __attribute__((ext_vector_type(4)));
typedef unsigned u32x2 __attribute__((ext_vector_type(2)));
constexpr int NTHR = 512, NWAVES = 8;
constexpr int B_ = 8, S_ = 4096, T_ = B_ * S_, D_ = 1024, FF_ = 4096;
constexpr int NMEM = 256, TM_ = B_ * NMEM;
constexpr int P0W = 2560;
constexpr int P1W = 1024;
constexpr int QW = 1280;
constexpr int KVW = 1536;
constexpr int NCH = 32;
constexpr int CT_ROWS = 208;
constexpr size_t MiB = 1u << 20;
constexpr size_t WS_ROWSQ = 0;
constexpr size_t WS_GATES = 1 * MiB;
constexpr size_t WS_CS = 2 * MiB;
constexpr size_t WS_SCAL = 6 * MiB;
constexpr size_t WS_MPREV = 6 * MiB + 65536;
constexpr size_t WS_MEMKV = 8 * MiB;
constexpr size_t WS_MEMBF = 10 * MiB;
constexpr size_t WS_WIN0 = 16 * MiB, WS_WMEM = 21 * MiB, WS_WOUT0 = 22 * MiB, WS_WFF1_0 = 24 * MiB, WS_WFF2_0 = 32 * MiB, WS_WIN1 = 40 * MiB,
                 WS_WUQ = 42 * MiB, WS_WUKV = 43 * MiB, WS_WOUT1 = 44 * MiB, WS_WFF1_1 = 46 * MiB, WS_WFF2_1 = 54 * MiB;
constexpr size_t WS_XB = 64 * MiB;
constexpr size_t WS_Y = 128 * MiB;
constexpr size_t WS_CT = 192 * MiB;
constexpr size_t WS_BIG = 232 * MiB;
constexpr size_t WS_END = 488 * MiB;
constexpr int LDS_BYTES = 147456;

DI float bf2f(unsigned short h) { return __uint_as_float(((unsigned)h) << 16); }
DI unsigned short f2bf(float f) { return __builtin_bit_cast(unsigned short, (__bf16)f); }
typedef float f32x2 __attribute__((ext_vector_type(2)));
typedef __bf16 bf16x2_t __attribute__((ext_vector_type(2)));
DI unsigned pk2(float lo, float hi) { const f32x2 v = {lo, hi}; return __builtin_bit_cast(unsigned, __builtin_convertvector(v, bf16x2_t)); }
DI float wave_sum(float v) {
#pragma unroll
    for (int o = 1; o < 64; o <<= 1) v += __shfl_xor(v, o);
    return v;
}
DI float xor32_max(float x) { const auto r = __builtin_amdgcn_permlane32_swap(__float_as_uint(x), __float_as_uint(x), false, false); return fmaxf(__uint_as_float(r[0]), __uint_as_float(r[1])); }
DI float xor32_sum(float x) { const auto r = __builtin_amdgcn_permlane32_swap(__float_as_uint(x), __float_as_uint(x), false, false); return __uint_as_float(r[0]) + __uint_as_float(r[1]); }
DI float silu(float x) { return x * __builtin_amdgcn_rcpf(1.f + __expf(-x)); }
#define LDS_WAIT() asm volatile("s_waitcnt lgkmcnt(0)" ::: "memory")
#define MFMA16(a, b, c) __builtin_amdgcn_mfma_f32_16x16x32_bf16((a), (b), (c), 0, 0, 0)

typedef KArgs Args;
DI const float* inp(const Args& a, int i) { asm volatile("" : "+s"(i)); return a.in[i]; }
enum { I_X = 0, I_MEM, I_POS, I_MEMNORM, I_WMEMKV, I_NORMMIX0, I_WIN0, I_BI, I_BF, I_WCONV, I_WHNORM, I_WOUT0, I_NORMFFN0, I_WFF1_0, I_WFF2_0,
       I_NORMMIX1, I_WIN1, I_WQNORM, I_WUQ, I_WKVNORM, I_WUKV, I_WOUT1, I_NORMFFN1, I_WFF1_1, I_WFF2_1, I_FINALNORM };

DI int srccol(int map, int n) {
    if (map == 1) return n < 2304 ? n : n + 8;
    if (map == 2) {
        if (n < 256) return 384 + n;
        if (n < 640) return n - 256;
        if (n < 672) { const int j = n - 640; return 640 + (j & 1) * 16 + (j >> 1); }
        if (n < 768) return -1;
        return 672 + (n - 768);
    }
    if (map == 3) {
        if (n >= 1152) return -1;
        const int h = n / 96, j = n % 96;
        if (j < 64) return h * 96 + j;
        const int jj = j - 64; return h * 96 + 64 + (jj & 1) * 16 + (jj >> 1);
    }
    return n;
}
DI void cvt_item(const float* W, int K, int Nsrc, int Ndst, int map, const float* gain, bf16* WT, LAS float* scr, int item, int lane) {
    const int nblk = Ndst / 32, kb = item / nblk, nb = item % nblk, k0 = 64 * kb, n0 = 32 * nb;
    const int sc = srccol(map, n0 + (lane & 31));
    float wv[32];
#pragma unroll
    for (int i = 0; i < 32; ++i) { const int kk = 2 * i + (lane >> 5); wv[i] = (sc >= 0) ? W[(size_t)(k0 + kk) * Nsrc + sc] : 0.f; }
    const int c = lane & 7;
    f32x4 g0 = (f32x4){1.f, 1.f, 1.f, 1.f}, g1 = g0;
    if (gain) { g0 = *(const f32x4*)(gain + k0 + 8 * c); g1 = *(const f32x4*)(gain + k0 + 8 * c + 4); }
#pragma unroll
    for (int i = 0; i < 32; ++i) { const int kk = 2 * i + (lane >> 5); scr[kk * 33 + (lane & 31)] = wv[i]; }
    LDS_WAIT(); asm volatile("" ::: "memory");
#pragma unroll
    for (int j = 0; j < 4; ++j) { const int n = (lane >> 3) + 8 * j; const LAS float* s = scr + (8 * c) * 33 + n;
        u32x4 o; o.x = pk2(s[0 * 33] * g0.x, s[1 * 33] * g0.y); o.y = pk2(s[2 * 33] * g0.z, s[3 * 33] * g0.w); o.z = pk2(s[4 * 33] * g1.x, s[5 * 33] * g1.y); o.w = pk2(s[6 * 33] * g1.z, s[7 * 33] * g1.w);
        *(u32x4*)(WT + (size_t)(n0 + n) * K + k0 + 8 * c) = o; }
    LDS_WAIT(); asm volatile("" ::: "memory");
}
DI float logsigmoid(float z) { return fminf(z, 0.f) - __logf(1.f + __expf(-fabsf(z))); }

DI void p0_prologue(const Args& a, LAS unsigned char* lds, int gw, int NGW, int lane, int wave, int tid) {
    __attribute__((address_space(1))) unsigned char* wsg_ = (__attribute__((address_space(1))) unsigned char*)a.ws; asm volatile("" : "+s"(wsg_)); unsigned char* ws = (unsigned char*)wsg_;
    LAS float* scr = (LAS float*)(lds + wave * 8448);
    LAS float* gwl = (LAS float*)(lds + 73728);
    { const float* W = inp(a, I_WIN0); const float* g = inp(a, I_NORMMIX0);
      for (int e = tid; e < 1024 * 8; e += NTHR) { const int k = e >> 3, c = e & 7; gwl[(((((k >> 8) * 4 + (k & 3)) * 2 + (c >> 2)) * 64 + ((k & 255) >> 2)) << 2) + (c & 3)] = W[(size_t)k * 2568 + 2304 + c] * g[k]; } }
#define CV(W_, K_, NS_, ND_, MAP_, G_, OFF_) { constexpr int items = (K_ / 64) * (ND_ / 32); if (r < items) { cvt_item(inp(a, W_), K_, NS_, ND_, MAP_, (G_) >= 0 ? inp(a, (G_) >= 0 ? (G_) : 0) : nullptr, (bf16*)(ws + OFF_), scr, r, lane); continue; } r -= items; }
    constexpr int NITEMS = 16 * 80 + 16 * 16 + 16 * 32 + 16 * 128 + 64 * 32 + 16 * 32 + 6 * 40 + 4 * 48 + 16 * 32 + 16 * 128 + 64 * 32;
    for (int it = gw; it < NITEMS; it += NGW) {
        int r = it;
        CV(I_WIN0, 1024, 2568, 2560, 1, I_NORMMIX0, WS_WIN0)
        CV(I_WMEMKV, 1024, 512, 512, 0, I_MEMNORM, WS_WMEM)
        CV(I_WOUT0, 1024, 1024, 1024, 0, -1, WS_WOUT0)
        CV(I_WFF1_0, 1024, 4096, 4096, 0, I_NORMFFN0, WS_WFF1_0)
        CV(I_WFF2_0, 4096, 1024, 1024, 0, -1, WS_WFF2_0)
        CV(I_WIN1, 1024, 928, 1024, 2, I_NORMMIX1, WS_WIN1)
        CV(I_WUQ, 384, 1152, 1280, 3, I_WQNORM, WS_WUQ)
        CV(I_WUKV, 256, 1536, 1536, 0, I_WKVNORM, WS_WUKV)
        CV(I_WOUT1, 1024, 1024, 1024, 0, -1, WS_WOUT1)
        CV(I_WFF1_1, 1024, 4096, 4096, 0, I_NORMFFN1, WS_WFF1_1)
        CV(I_WFF2_1, 4096, 1024, 1024, 0, -1, WS_WFF2_1)
    }
#undef CV
    __syncthreads();
    float* rowsq = (float*)(ws + WS_ROWSQ); float* gates = (float*)(ws + WS_GATES);
    const float* bi = inp(a, I_BI); const float* bfg = inp(a, I_BF);
    for (int m0 = gw; m0 < T_; m0 += 2 * NGW) {
        f32x4 xv[2][4];
#pragma unroll
        for (int rr = 0; rr < 2; ++rr) { const int m = min(m0 + rr * NGW, T_ - 1); const f32x4* xr = (const f32x4*)(inp(a, I_X) + (size_t)m * D_) + lane;
#pragma unroll
                for (int j = 0; j < 4; ++j) xv[rr][j] = xr[64 * j]; }
#pragma unroll
        for (int rr = 0; rr < 2; ++rr) { const int m = m0 + rr * NGW; if (m < T_) {
            unsigned long long* o8 = (unsigned long long*)((bf16*)(ws + WS_XB) + (size_t)m * D_) + lane;
            float s = 0.f, g8[8];
#pragma unroll
            for (int j = 0; j < 8; ++j) g8[j] = 0.f;
#pragma unroll
            for (int j = 0; j < 4; ++j) { const f32x4 v = xv[rr][j]; s += (v.x * v.x + v.y * v.y) + (v.z * v.z + v.w * v.w);
                o8[64 * j] = (unsigned long long)pk2(v.x, v.y) | ((unsigned long long)pk2(v.z, v.w) << 32);
                const LAS f32x4* gq = (const LAS f32x4*)gwl + (j * 8) * 64 + lane;
#pragma unroll
                for (int e = 0; e < 4; ++e) { const f32x4 w0 = gq[(2 * e) * 64], w1 = gq[(2 * e + 1) * 64]; const float xe = v[e];
                    g8[0] += xe * w0.x; g8[1] += xe * w0.y; g8[2] += xe * w0.z; g8[3] += xe * w0.w; g8[4] += xe * w1.x; g8[5] += xe * w1.y; g8[6] += xe * w1.z; g8[7] += xe * w1.w; } }
            s = wave_sum(s);
#pragma unroll
            for (int j = 0; j < 8; ++j) g8[j] = wave_sum(g8[j]);
            const float rstd = rsqrtf(s * (1.f / D_) + RMS_EPS);
            if (lane == 0) rowsq[m] = s;
            if (lane < 8) { float gv = g8[0];
#pragma unroll
                for (int j = 1; j < 8; ++j) gv = (lane == j) ? g8[j] : gv;
                gv *= rstd;
                gates[(size_t)m * 8 + lane] = (lane < 4) ? gv + bi[lane] : logsigmoid(gv + bfg[lane - 4]); }
        } }
    }
    for (int m = gw; m < TM_; m += NGW) {
        const f32x4* xr = (const f32x4*)(inp(a, I_MEM) + (size_t)m * D_) + lane;
        unsigned long long* o8 = (unsigned long long*)((bf16*)(ws + WS_MEMBF) + (size_t)m * D_) + lane;
        float s = 0.f;
#pragma unroll
        for (int j = 0; j < 4; ++j) { const f32x4 v = xr[64 * j]; s += (v.x * v.x + v.y * v.y) + (v.z * v.z + v.w * v.w);
            o8[64 * j] = (unsigned long long)pk2(v.x, v.y) | ((unsigned long long)pk2(v.z, v.w) << 32); }
        s = wave_sum(s);
        if (lane == 0) rowsq[7 * T_ + m] = s;
    }
    const int gt = gw * 64 + lane, NGT = NGW * 64;
    for (int i = gt; i < 6 * T_; i += NGT) rowsq[T_ + i] = 0.f;
    { const int* pos = (const int*)inp(a, I_POS); float* cs = (float*)(ws + WS_CS);
      for (int i = gt; i < T_ * 16; i += NGT) { const int t = i >> 4, p = i & 15;
          const float inv = exp2f(-(float)p * (13.287712379549449f / 16.f));
          const float ang = (float)pos[t] * inv;
          double rev = (double)ang * 0.15915494309189535; rev -= floor(rev);
          const float rv = (float)rev;
          cs[2 * i] = __builtin_amdgcn_cosf(rv); cs[2 * i + 1] = __builtin_amdgcn_sinf(rv); } }
}
DI void conv8(const bf16* P0, const float* wconv, size_t t, int spos, int ch0, float (&o)[8]) {
#pragma unroll
    for (int i = 0; i < 8; ++i) o[i] = 0.f;
#pragma unroll
    for (int j = 0; j < 4; ++j) {
        const int dt = j - 3;
        if (spos + dt >= 0) {
            const u32x4 raw = *(const u32x4*)(P0 + (size_t)((long)t + dt) * P0W + ch0);
            const f32x4 w0 = *(const f32x4*)(wconv + j * 768 + ch0), w1 = *(const f32x4*)(wconv + j * 768 + ch0 + 4);
            o[0] += w0.x * __uint_as_float(raw.x << 16); o[1] += w0.y * __uint_as_float(raw.x & 0xffff0000u);
            o[2] += w0.z * __uint_as_float(raw.y << 16); o[3] += w0.w * __uint_as_float(raw.y & 0xffff0000u);
            o[4] += w1.x * __uint_as_float(raw.z << 16); o[5] += w1.y * __uint_as_float(raw.z & 0xffff0000u);
            o[6] += w1.z * __uint_as_float(raw.w << 16); o[7] += w1.w * __uint_as_float(raw.w & 0xffff0000u);
        }
    }
#pragma unroll
    for (int i = 0; i < 8; ++i) o[i] = silu(o[i]);
}
constexpr float KSCALE = 0.10206207261596575f;

DI void mlstm_local_unit(const Args& a, LAS unsigned char* lds, int unit, int tid, int lane, int wave) {
    __attribute__((address_space(1))) unsigned char* wsg_ = (__attribute__((address_space(1))) unsigned char*)a.ws; asm volatile("" : "+s"(wsg_)); unsigned char* ws = (unsigned char*)wsg_;
    const int bh = unit >> 5, c = unit & 31, b = bh >> 2, h = bh & 3;
    const size_t t0 = (size_t)b * S_ + (size_t)c * 128;
    const bf16* P0 = (const bf16*)(ws + WS_BIG);
    const float* gates = (const float*)(ws + WS_GATES);
    LAS float* su = (LAS float*)lds;
    LAS bf16* Kt = (LAS bf16*)(lds + 1024);
    LAS bf16* Vt = (LAS bf16*)(lds + 1024 + 96 * 272);
    const int s = tid & 127, gq = tid >> 7;
    LAS bf16* Rw = (LAS bf16*)(lds + 1024 + 96 * 272 + 192 * 272);
    u32x4 rvv[6];
#pragma unroll
    for (int r = 0; r < 6; ++r) rvv[r] = *(const u32x4*)(P0 + (t0 + s) * P0W + 768 + h * 192 + (gq + 4 * r) * 8);
    { u32x4 rr[7];
#pragma unroll
      for (int i = 0; i < 7; ++i) { const int e = min(tid + NTHR * i, 131 * 24 - 1), row = e / 24, cg = e % 24;
          const long tr = (long)t0 - 3 + row; const bool ok_ = (c * 128 - 3 + row) >= 0;
          rr[i] = ok_ ? *(const u32x4*)(P0 + (size_t)(ok_ ? tr : 0) * P0W + (cg < 12 ? h * 96 + cg * 8 : 384 + h * 96 + (cg - 12) * 8)) : (u32x4){0u, 0u, 0u, 0u}; }
#pragma unroll
      for (int i = 0; i < 7; ++i) { const int e = tid + NTHR * i; if (e < 131 * 24) *(LAS u32x4*)(Rw + (e / 24) * 200 + (e % 24) * 8) = rr[i]; } }
    if (wave == 0) {
        const float lf0 = gates[(t0 + 2 * lane) * 8 + 4 + h], lf1 = gates[(t0 + 2 * lane + 1) * 8 + 4 + h];
        const float li0 = gates[(t0 + 2 * lane) * 8 + h], li1 = gates[(t0 + 2 * lane + 1) * 8 + h];
        float p = lf0 + lf1;
#pragma unroll
        for (int o = 1; o < 64; o <<= 1) { const float q = __shfl_up(p, o); if (lane >= o) p += q; }
        const float b1 = p, b0 = p - lf1;
        const float g0 = li0 - b0, g1 = li1 - b1;
        float gm = fmaxf(g0, g1);
#pragma unroll
        for (int o = 1; o < 64; o <<= 1) gm = fmaxf(gm, __shfl_xor(gm, o));
        su[2 * lane] = __expf(g0 - gm); su[2 * lane + 1] = __expf(g1 - gm);
        const float bend = __shfl(b1, 63);
        if (lane == 0) { float* sc = (float*)(ws + WS_SCAL) + 2 * unit; sc[0] = bend; sc[1] = bend + gm; }
    }
    __syncthreads();
    bf16* QKc = (bf16*)(ws + WS_XB) + (t0 + s) * 768 + h * 96;
    const float us = su[s];
    const float* wconv = inp(a, I_WCONV);
#pragma unroll
    for (int r = 0; r < 6; ++r) {
        const int cg = gq + 4 * r, isk = cg >= 12, dg = isk ? cg - 12 : cg, ch0 = (isk ? 384 : 0) + h * 96 + dg * 8;
        float o[8];
#pragma unroll
        for (int i = 0; i < 8; ++i) o[i] = 0.f;
#pragma unroll
        for (int j = 0; j < 4; ++j) {
            const u32x4 raw = *(const LAS u32x4*)(Rw + (s + j) * 200 + cg * 8);
            const f32x4 w0 = *(const f32x4*)(wconv + j * 768 + ch0), w1 = *(const f32x4*)(wconv + j * 768 + ch0 + 4);
            o[0] += w0.x * __uint_as_float(raw.x << 16); o[1] += w0.y * __uint_as_float(raw.x & 0xffff0000u);
            o[2] += w0.z * __uint_as_float(raw.y << 16); o[3] += w0.w * __uint_as_float(raw.y & 0xffff0000u);
            o[4] += w1.x * __uint_as_float(raw.z << 16); o[5] += w1.y * __uint_as_float(raw.z & 0xffff0000u);
            o[6] += w1.z * __uint_as_float(raw.w << 16); o[7] += w1.w * __uint_as_float(raw.w & 0xffff0000u);
        }
        const float ksc = isk ? KSCALE : 1.f;
#pragma unroll
        for (int i = 0; i < 8; ++i) o[i] = silu(o[i]) * ksc;
        u32x4 w; w.x = pk2(o[0], o[1]); w.y = pk2(o[2], o[3]); w.z = pk2(o[4], o[5]); w.w = pk2(o[6], o[7]); *(u32x4*)(QKc + (isk ? 384 : 0) + dg * 8) = w;
        if (isk) {
#pragma unroll
            for (int i = 0; i < 8; ++i) Kt[(dg * 8 + i) * 136 + s] = f2bf(o[i] * us); }
    }
#pragma unroll
    for (int r = 0; r < 6; ++r) {
        const int vg = gq + 4 * r; const u32x4 raw = rvv[r];
        Vt[(vg * 8 + 0) * 136 + s] = (bf16)(raw.x & 0xffff); Vt[(vg * 8 + 1) * 136 + s] = (bf16)(raw.x >> 16);
        Vt[(vg * 8 + 2) * 136 + s] = (bf16)(raw.y & 0xffff); Vt[(vg * 8 + 3) * 136 + s] = (bf16)(raw.y >> 16);
        Vt[(vg * 8 + 4) * 136 + s] = (bf16)(raw.z & 0xffff); Vt[(vg * 8 + 5) * 136 + s] = (bf16)(raw.z >> 16);
        Vt[(vg * 8 + 6) * 136 + s] = (bf16)(raw.w & 0xffff); Vt[(vg * 8 + 7) * 136 + s] = (bf16)(raw.w >> 16);
    }
    __syncthreads();
    float* U = (float*)(ws + WS_BIG + 160 * MiB) + (size_t)unit * (193 * 96);
    if (tid < 384) {
        const int d = tid >> 2, part = tid & 3; float sum = 0.f;
#pragma unroll 8
        for (int i = 0; i < 32; ++i) sum += bf2f(Kt[d * 136 + part * 32 + i]);
        sum += __shfl_xor(sum, 1); sum += __shfl_xor(sum, 2);
        if (part == 0) U[192 * 96 + d] = sum;
    }
    {
        const int dgp = wave & 1, vgp = wave >> 1, r16 = lane & 15, g = lane >> 4;
        f32x4 acc[3][3];
#pragma unroll
        for (int i = 0; i < 3; ++i)
#pragma unroll
            for (int j = 0; j < 3; ++j) acc[i][j] = (f32x4){0.f, 0.f, 0.f, 0.f};
#pragma unroll
        for (int ks = 0; ks < 4; ++ks) {
            bf16x8 af[3], bfr[3];
#pragma unroll
            for (int i = 0; i < 3; ++i) af[i] = *(const LAS bf16x8*)(Kt + ((dgp * 3 + i) * 16 + r16) * 136 + ks * 32 + g * 8);
#pragma unroll
            for (int j = 0; j < 3; ++j) bfr[j] = *(const LAS bf16x8*)(Vt + ((vgp * 3 + j) * 16 + r16) * 136 + ks * 32 + g * 8);
#pragma unroll
            for (int i = 0; i < 3; ++i)
#pragma unroll
                for (int j = 0; j < 3; ++j) acc[i][j] = MFMA16(af[i], bfr[j], acc[i][j]);
        }
#pragma unroll
        for (int i = 0; i < 3; ++i)
#pragma unroll
            for (int j = 0; j < 3; ++j) *(f32x4*)(U + (size_t)((vgp * 3 + j) * 16 + r16) * 96 + (dgp * 3 + i) * 16 + g * 4) = acc[i][j];
    }
    __syncthreads();
}

DI void memattn_unit(const Args& a, LAS unsigned char* lds, const bf16* Qp, int ldq, int qcol0, int unit, int tid, int lane, int wave) {
    __attribute__((address_space(1))) unsigned char* wsg_ = (__attribute__((address_space(1))) unsigned char*)a.ws; asm volatile("" : "+s"(wsg_)); unsigned char* ws = (unsigned char*)wsg_;
    const int rb4 = unit & 7, bh = unit >> 3, b = bh >> 2, h = bh & 3;
    const bf16* MKV = (const bf16*)(ws + WS_MEMKV) + (size_t)b * NMEM * 512;
    LAS bf16* Km = (LAS bf16*)lds;
    LAS bf16* Vt = (LAS bf16*)(lds + 36864);
    LAS bf16* Qs = (LAS bf16*)(lds + 36864 + 33792);
#pragma unroll
    for (int r = 0; r < 4; ++r) { const int gi = tid + NTHR * r, key = gi >> 3, dg = gi & 7;
        *(LAS u32x4*)(Km + key * 72 + dg * 8) = *(const u32x4*)(MKV + (size_t)key * 512 + h * 64 + dg * 8); }
#pragma unroll
    for (int r = 0; r < 4; ++r) { const int gi = tid + NTHR * r, key = gi & 255, vg = gi >> 8;
        const u32x4 raw = *(const u32x4*)(MKV + (size_t)key * 512 + 256 + h * 64 + vg * 8);
        Vt[(vg * 8 + 0) * 264 + key] = (bf16)(raw.x & 0xffff); Vt[(vg * 8 + 1) * 264 + key] = (bf16)(raw.x >> 16);
        Vt[(vg * 8 + 2) * 264 + key] = (bf16)(raw.y & 0xffff); Vt[(vg * 8 + 3) * 264 + key] = (bf16)(raw.y >> 16);
        Vt[(vg * 8 + 4) * 264 + key] = (bf16)(raw.z & 0xffff); Vt[(vg * 8 + 5) * 264 + key] = (bf16)(raw.z >> 16);
        Vt[(vg * 8 + 6) * 264 + key] = (bf16)(raw.w & 0xffff); Vt[(vg * 8 + 7) * 264 + key] = (bf16)(raw.w >> 16); }
#pragma unroll 1
    for (int sb = 0; sb < 4; ++sb) {
    const size_t t0 = (size_t)b * S_ + (size_t)(rb4 * 4 + sb) * 128;
#pragma unroll
    for (int r = 0; r < 2; ++r) { const int gi = tid + NTHR * r, q = gi >> 3, dg = gi & 7;
        *(LAS u32x4*)(Qs + q * 72 + dg * 8) = *(const u32x4*)(Qp + (t0 + q) * ldq + qcol0 + h * 64 + dg * 8); }
    __syncthreads();
    const int r16 = lane & 15, g = lane >> 4, q0 = wave * 16;
    bf16x8 qf[2];
#pragma unroll
    for (int ks = 0; ks < 2; ++ks) qf[ks] = *(const LAS bf16x8*)(Qs + (q0 + r16) * 72 + ks * 32 + g * 8);
    f32x4 sc[16];
#pragma unroll
    for (int kt = 0; kt < 16; ++kt) { sc[kt] = (f32x4){0.f, 0.f, 0.f, 0.f};
#pragma unroll
        for (int ks = 0; ks < 2; ++ks) { const bf16x8 kf = *(const LAS bf16x8*)(Km + (kt * 16 + r16) * 72 + ks * 32 + g * 8); sc[kt] = MFMA16(kf, qf[ks], sc[kt]); } }
    float mxa[4] = {-INFINITY, -INFINITY, -INFINITY, -INFINITY};
#pragma unroll
    for (int kt = 0; kt < 16; ++kt) mxa[kt & 3] = fmaxf(mxa[kt & 3], fmaxf(fmaxf(sc[kt][0], sc[kt][1]), fmaxf(sc[kt][2], sc[kt][3])));
    float mx = fmaxf(fmaxf(mxa[0], mxa[1]), fmaxf(mxa[2], mxa[3]));
    mx = fmaxf(mx, __shfl_xor(mx, 16)); mx = xor32_max(mx);
    const float c2 = 0.125f * 1.4426950408889634f; float sm4[4] = {0.f, 0.f, 0.f, 0.f};
#pragma unroll
    for (int kt = 0; kt < 16; ++kt)
#pragma unroll
        for (int i = 0; i < 4; ++i) { const float p = __builtin_amdgcn_exp2f((sc[kt][i] - mx) * c2); sc[kt][i] = p; sm4[i] += p; }
    float sum = (sm4[0] + sm4[1]) + (sm4[2] + sm4[3]);
    sum += __shfl_xor(sum, 16); sum = xor32_sum(sum);
    f32x4 oa[4];
#pragma unroll
    for (int vt = 0; vt < 4; ++vt) oa[vt] = (f32x4){0.f, 0.f, 0.f, 0.f};
#pragma unroll
    for (int k2 = 0; k2 < 8; ++k2) {
        u32x4 pw; pw.x = pk2(sc[2 * k2][0], sc[2 * k2][1]); pw.y = pk2(sc[2 * k2][2], sc[2 * k2][3]); pw.z = pk2(sc[2 * k2 + 1][0], sc[2 * k2 + 1][1]); pw.w = pk2(sc[2 * k2 + 1][2], sc[2 * k2 + 1][3]);
        const bf16x8 pf = __builtin_bit_cast(bf16x8, pw);
#pragma unroll
        for (int vt = 0; vt < 4; ++vt) {
            const s16x4 lo = *(const LAS s16x4*)(Vt + (vt * 16 + r16) * 264 + 32 * k2 + g * 4), hi = *(const LAS s16x4*)(Vt + (vt * 16 + r16) * 264 + 32 * k2 + 16 + g * 4);
            const bf16x8 vf = __builtin_shufflevector(lo, hi, 0, 1, 2, 3, 4, 5, 6, 7);
            oa[vt] = MFMA16(vf, pf, oa[vt]);
        }
    }
    const float inv = 1.f / sum;
    bf16* Y = (bf16*)(ws + WS_Y) + (t0 + q0 + r16) * D_ + 768 + h * 64;
#pragma unroll
    for (int vt = 0; vt < 4; ++vt) { u32x2 w; w.x = pk2(oa[vt][0] * inv, oa[vt][1] * inv); w.y = pk2(oa[vt][2] * inv, oa[vt][3] * inv); *(u32x2*)(Y + vt * 16 + g * 4) = w; }
    __syncthreads();
    }
}

DI void mlstm_scan(const Args& a, int gt, int NGT) {
    __attribute__((address_space(1))) unsigned char* wsg_ = (__attribute__((address_space(1))) unsigned char*)a.ws; asm volatile("" : "+s"(wsg_)); unsigned char* ws = (unsigned char*)wsg_;
    const float* U = (const float*)(ws + WS_BIG + 160 * MiB);
    bf16* Ct = (bf16*)(ws + WS_CT);
    const float* scal = (const float*)(ws + WS_SCAL);
    float* mprev = (float*)(ws + WS_MPREV);
    constexpr int NE = 193 * 96, NE4 = NE / 4;
    for (int idx = gt; idx < 32 * NE4; idx += NGT) {
        const int bh = idx / NE4, e = (idx - bh * NE4) * 4;
        float m = 0.f; f32x4 C = (f32x4){0.f, 0.f, 0.f, 0.f};
        f32x4 u[NCH];
#pragma unroll
        for (int c = 0; c < NCH; ++c) u[c] = *(const f32x4*)(U + (size_t)(bh * NCH + c) * NE + e);
#pragma unroll
        for (int c = 0; c < NCH; ++c) {
            const int unit = bh * NCH + c;
            const float be = scal[2 * unit], ml = scal[2 * unit + 1];
            const float mn = fmaxf(be + m, ml), dec = __expf(be + m - mn), sc = __expf(ml - mn);
            u32x2 w; w.x = pk2(C[0], C[1]); w.y = pk2(C[2], C[3]);
            *(u32x2*)(Ct + (size_t)unit * (CT_ROWS * 96) + e) = w;
            if (e == 0) mprev[unit] = m;
            C = C * dec + u[c] * sc;
            m = mn;
        }
    }
    for (int idx = gt; idx < 1024 * 15 * 96; idx += NGT) { const int unit = idx / (15 * 96), e = idx - unit * (15 * 96); Ct[(size_t)unit * (CT_ROWS * 96) + 193 * 96 + e] = 0; }
}
DI void mlstm_out_phase(const Args& a, LAS unsigned char* lds, int bx, int G, int tid_in) {
    u32x4 rq[2], rkk[3], rvv[6], rct[5]; float rg[4], rmp;
#define MLO_LOADS(u2_) do { const int rh_ = (u2_) & 1, un_ = (u2_) >> 1, bh_ = un_ >> 5, c_ = un_ & 31, b_ = bh_ >> 2, h_ = bh_ & 3; const size_t t0_ = (size_t)b_ * S_ + (size_t)c_ * 128; \
        _Pragma("unroll") for (int i = 0; i < 2; ++i) { const int e = min(tid + NTHR * i, 767); rq[i] = *(const u32x4*)(QKc + (t0_ + rh_ * 64 + e / 12) * 768 + h_ * 96 + (e % 12) * 8); } \
        _Pragma("unroll") for (int i = 0; i < 3; ++i) { const int e = tid + NTHR * i; rkk[i] = *(const u32x4*)(QKc + (t0_ + e / 12) * 768 + 384 + h_ * 96 + (e % 12) * 8); } \
        _Pragma("unroll") for (int r = 0; r < 6; ++r) rvv[r] = *(const u32x4*)(P0 + (t0_ + (tid & 127)) * P0W + 768 + h_ * 192 + ((tid >> 7) + 4 * r) * 8); \
        { const float* gt_ = (const float*)(ws + WS_GATES) + (t0_ + 2 * (tid & 63)) * 8 + h_; rg[0] = gt_[4]; rg[1] = gt_[12]; rg[2] = gt_[0]; rg[3] = gt_[8]; rmp = ((const float*)(ws + WS_MPREV))[un_]; } \
        { const bf16* Ct_ = (const bf16*)(ws + WS_CT) + (size_t)un_ * (CT_ROWS * 96); \
          _Pragma("unroll") for (int i = 0; i < 5; ++i) { const int e = min(tid + NTHR * i, CT_ROWS * 12 - 1); rct[i] = *(const u32x4*)(Ct_ + e * 8); } } } while (0)
    { __attribute__((address_space(1))) unsigned char* wsg0_ = (__attribute__((address_space(1))) unsigned char*)a.ws; asm volatile("" : "+s"(wsg0_)); unsigned char* ws = (unsigned char*)wsg0_;
      const int tid = tid_in; const bf16* P0 = (const bf16*)(ws + WS_BIG); const bf16* QKc = (const bf16*)(ws + WS_XB);
      MLO_LOADS(min(bx, 2047)); }
#pragma unroll 1
    for (int unit2 = bx; unit2 < 2048; unit2 += G) {
    __attribute__((address_space(1))) unsigned char* wsg_ = (__attribute__((address_space(1))) unsigned char*)a.ws; asm volatile("" : "+s"(wsg_)); unsigned char* ws = (unsigned char*)wsg_;
    int tid = tid_in; asm volatile("" : "+v"(tid)); const int lane = tid & 63, wave = tid >> 6;
    const int rh = unit2 & 1, unit = unit2 >> 1, bh = unit >> 5, c = unit & 31, b = bh >> 2, h = bh & 3;
    const size_t t0 = (size_t)b * S_ + (size_t)c * 128;
    const bf16* P0 = (const bf16*)(ws + WS_BIG);
    const bf16* QKc = (const bf16*)(ws + WS_XB);
    LAS float* sM = (LAS float*)lds;
    LAS float* sA = sM + 64;
    LAS float* sE = sM + 128;
    LAS float* sG = sM + 192;
    LAS float* sD = sM + 320;
    LAS float* sQ = sM + 384;
    LAS bf16* A2 = (LAS bf16*)(lds + 4096);
    LAS bf16* B2 = (LAS bf16*)(lds + 4096 + 64 * 464);
    LAS bf16* Ks = B2;
    LAS bf16* Yt = A2;
    const int sv = tid & 127, gq = tid >> 7;
    if (wave == 0) {
        const float lf0 = rg[0], lf1 = rg[1], li0 = rg[2], li1 = rg[3];
        float p = lf0 + lf1;
#pragma unroll
        for (int o = 1; o < 64; o <<= 1) { const float q = __shfl_up(p, o); if (lane >= o) p += q; }
        const float b1 = p, b0 = p - lf1;
        const float g0 = li0 - b0, g1 = li1 - b1;
        float pm = fmaxf(g0, g1);
#pragma unroll
        for (int o = 1; o < 64; o <<= 1) { const float q = __shfl_up(pm, o); if (lane >= o) pm = fmaxf(pm, q); }
        float pmx = __shfl_up(pm, 1); if (lane == 0) pmx = -INFINITY;
        const float pm0 = fmaxf(pmx, g0), pm1 = pm;
        sG[2 * lane] = g0; sG[2 * lane + 1] = g1;
        const float mp = rmp;
        const int jl = 2 * lane - rh * 64;
        if (jl >= 0 && jl < 64) {
            const float M0 = fmaxf(mp, pm0), M1 = fmaxf(mp, pm1);
            sM[jl] = M0; sM[jl + 1] = M1; sA[jl] = __expf(mp - M0); sA[jl + 1] = __expf(mp - M1);
            sE[jl] = __expf(-(b0 + M0)); sE[jl + 1] = __expf(-(b1 + M1));
        }
    }
#pragma unroll
    for (int i = 0; i < 2; ++i) { const int e = tid + NTHR * i; if (e < 768) *(LAS u32x4*)(A2 + (e / 12) * 232 + 128 + (e % 12) * 8) = rq[i]; }
#pragma unroll
    for (int i = 0; i < 3; ++i) { const int e = tid + NTHR * i; *(LAS u32x4*)(Ks + (e / 12) * 104 + (e % 12) * 8) = rkk[i]; }
    __syncthreads();
    const int r16 = lane & 15, g = lane >> 4, rt = wave & 3, wh = wave >> 2;
    {
        f32x4 sacc[4];
#pragma unroll
        for (int j = 0; j < 4; ++j) sacc[j] = (f32x4){0.f, 0.f, 0.f, 0.f};
#pragma unroll
        for (int ks = 0; ks < 3; ++ks) {
            const bf16x8 qf = *(const LAS bf16x8*)(A2 + (rt * 16 + r16) * 232 + 128 + ks * 32 + g * 8);
#pragma unroll
            for (int j = 0; j < 4; ++j) { const bf16x8 kf = *(const LAS bf16x8*)(Ks + ((wh * 4 + j) * 16 + r16) * 104 + ks * 32 + g * 8); sacc[j] = MFMA16(qf, kf, sacc[j]); }
        }
#pragma unroll
        for (int j = 0; j < 4; ++j) { const int s = (wh * 4 + j) * 16 + r16; const float gs = sG[s];
#pragma unroll
            for (int i = 0; i < 4; ++i) { const int jl = rt * 16 + g * 4 + i; const float w = (s <= rh * 64 + jl) ? __expf(gs - sM[jl]) : 0.f; A2[jl * 232 + s] = f2bf(sacc[j][i] * w); } }
    }
    __syncthreads();
    for (int e = tid; e < 64 * 48; e += NTHR) { const int r = e / 48, cp = e % 48; LAS unsigned* p = (LAS unsigned*)(A2 + r * 232 + 128) + cp; const unsigned v = *p; const float s = sA[r];
        *p = pk2(__uint_as_float(v << 16) * s, __uint_as_float(v & 0xffff0000u) * s); }
#pragma unroll
    for (int r = 0; r < 6; ++r) { const int vg = gq + 4 * r; const u32x4 raw = rvv[r];
        B2[(vg * 8 + 0) * 232 + sv] = (bf16)(raw.x & 0xffff); B2[(vg * 8 + 1) * 232 + sv] = (bf16)(raw.x >> 16);
        B2[(vg * 8 + 2) * 232 + sv] = (bf16)(raw.y & 0xffff); B2[(vg * 8 + 3) * 232 + sv] = (bf16)(raw.y >> 16);
        B2[(vg * 8 + 4) * 232 + sv] = (bf16)(raw.z & 0xffff); B2[(vg * 8 + 5) * 232 + sv] = (bf16)(raw.z >> 16);
        B2[(vg * 8 + 6) * 232 + sv] = (bf16)(raw.w & 0xffff); B2[(vg * 8 + 7) * 232 + sv] = (bf16)(raw.w >> 16); }
    for (int e = tid; e < 16 * 128; e += NTHR) { const int r = e >> 7, ss = e & 127; B2[(192 + r) * 232 + ss] = (r == 0) ? (bf16)0x3f80 : (bf16)0; }
#pragma unroll
    for (int i = 0; i < 5; ++i) { const int e = tid + NTHR * i; if (e < CT_ROWS * 12) *(LAS u32x4*)(B2 + (e / 12) * 232 + 128 + (e % 12) * 8) = rct[i]; }
    MLO_LOADS(min(unit2 + G, 2047));
    __syncthreads();
    {
        const int vt0 = wh * 6;
        f32x4 oacc[7];
#pragma unroll
        for (int j = 0; j < 7; ++j) oacc[j] = (f32x4){0.f, 0.f, 0.f, 0.f};
#pragma unroll
        for (int ks = 0; ks < 7; ++ks) {
            const bf16x8 af = *(const LAS bf16x8*)(A2 + (rt * 16 + r16) * 232 + ks * 32 + g * 8);
#pragma unroll
            for (int j = 0; j < 7; ++j) { const bf16x8 bfr = *(const LAS bf16x8*)(B2 + ((vt0 + j) * 16 + r16) * 232 + ks * 32 + g * 8); oacc[j] = MFMA16(af, bfr, oacc[j]); }
        }
        if (wh == 1 && r16 == 0) {
#pragma unroll
            for (int i = 0; i < 4; ++i) sD[rt * 16 + g * 4 + i] = oacc[6][i];
        }
        u32x4 rop[3];
#pragma unroll
        for (int i = 0; i < 3; ++i) { const int e = tid + NTHR * i; rop[i] = *(const u32x4*)(P0 + (t0 + rh * 64 + e / 24) * P0W + 1536 + h * 192 + (e % 24) * 8); }
        __syncthreads();
        float hv[7][4]; float ssq[4] = {0.f, 0.f, 0.f, 0.f};
#pragma unroll
        for (int i = 0; i < 4; ++i) { const int jl = rt * 16 + g * 4 + i; const float dn = __builtin_amdgcn_rcpf(fmaxf(fabsf(sD[jl]), sE[jl]));
#pragma unroll
            for (int j = 0; j < 7; ++j) { const bool valid = (vt0 + j < 12) && !(wh == 1 && j == 0); const float x = valid ? oacc[j][i] * dn : 0.f; hv[j][i] = x; ssq[i] += x * x; } }
#pragma unroll
        for (int i = 0; i < 4; ++i) { float s = ssq[i]; s += __shfl_xor(s, 1); s += __shfl_xor(s, 2); s += __shfl_xor(s, 4); s += __shfl_xor(s, 8); if (r16 == 0) sQ[wh * 64 + rt * 16 + g * 4 + i] = s; }
        __syncthreads();
        const float* whn = inp(a, I_WHNORM) + h * 192;
#pragma unroll
        for (int j = 0; j < 7; ++j) { const int v = (vt0 + j) * 16 + r16; const bool valid = (vt0 + j < 12) && !(wh == 1 && j == 0); const float wv = whn[v < 192 ? v : 0];
#pragma unroll
            for (int i = 0; i < 4; ++i) { const int jl = rt * 16 + g * 4 + i; const float rs = rsqrtf((sQ[jl] + sQ[64 + jl]) * (1.f / 192.f) + RMS_EPS); if (valid) Yt[jl * 200 + v] = f2bf(hv[j][i] * rs * wv); } }
        __syncthreads();
        bf16* Y = (bf16*)(ws + WS_Y);
#pragma unroll
        for (int i = 0; i < 3; ++i) { const int e = tid + NTHR * i, row = e / 24, cg8 = (e % 24) * 8;
            const u32x4 yv = *(const LAS u32x4*)(Yt + row * 200 + cg8); const u32x4 op = rop[i]; u32x4 o;
#define SG2(yw, ow) pk2(__uint_as_float((yw) << 16) * __builtin_amdgcn_rcpf(1.f + __expf(-__uint_as_float((ow) << 16))), __uint_as_float((yw) & 0xffff0000u) * __builtin_amdgcn_rcpf(1.f + __expf(-__uint_as_float((ow) & 0xffff0000u))))
            o.x = SG2(yv.x, op.x); o.y = SG2(yv.y, op.y); o.z = SG2(yv.z, op.z); o.w = SG2(yv.w, op.w);
#undef SG2
            *(u32x4*)(Y + (t0 + rh * 64 + row) * D_ + h * 192 + cg8) = o; }
    }
    __syncthreads();
    }
#undef MLO_LOADS
}

typedef float f32x16 __attribute__((ext_vector_type(16)));
#define MFMA32(a, b, c) __builtin_amdgcn_mfma_f32_32x32x16_bf16((a), (b), (c), 0, 0, 0)
DI int crow32(int i, int hh) { return (i & 3) + 8 * (i >> 2) + 4 * hh; }
DI void mla_unit(const Args& a, LAS unsigned char* lds, int b, int h, int qb, int tid, int lane, int wave) {
    __attribute__((address_space(1))) unsigned char* wsg_ = (__attribute__((address_space(1))) unsigned char*)a.ws; asm volatile("" : "+s"(wsg_)); unsigned char* ws = (unsigned char*)wsg_;
    const bf16* P1 = (const bf16*)(ws + WS_BIG);
    const bf16* Qg = (const bf16*)(ws + WS_BIG + 64 * MiB);
    const bf16* KV = (const bf16*)(ws + WS_BIG + 144 * MiB);
    const size_t tb = (size_t)b * S_;
    const int n32 = lane & 31, hh = lane >> 5;
    const int q0 = qb * 512 + wave * 64;
    bf16x8 qf[2][6];
#pragma unroll
    for (int qs = 0; qs < 2; ++qs)
#pragma unroll
        for (int ks = 0; ks < 6; ++ks) qf[qs][ks] = *(const bf16x8*)(Qg + (tb + q0 + qs * 32 + n32) * QW + h * 96 + ks * 16 + hh * 8);
    f32x16 oa[2][2];
#pragma unroll
    for (int vt = 0; vt < 2; ++vt)
#pragma unroll
        for (int qs = 0; qs < 2; ++qs)
#pragma unroll
            for (int i = 0; i < 16; ++i) oa[vt][qs][i] = 0.f;
    float mrun[2] = {-INFINITY, -INFINITY}, lsum[2] = {0.f, 0.f};
    const int ntile = 4 * (qb + 1), wdiag = 8 * qb + wave;
    const int k0key = tid / 12, k0dg = tid % 12, k1key = min((tid + 512) / 12, 63), k1dg = (tid + 512) % 12;
    u32x4 rk0, rk1, rv;
#define MLA_LOAD(kt_, hf_) do { const size_t tk = tb + (size_t)(kt_) * 128 + (hf_) * 64; \
        rk0 = (k0dg < 8) ? *(const u32x4*)(KV + (tk + k0key) * KVW + h * 128 + k0dg * 8) : *(const u32x4*)(P1 + (tk + k0key) * P1W + 640 + (k0dg - 8) * 8); \
        rk1 = (k1dg < 8) ? *(const u32x4*)(KV + (tk + k1key) * KVW + h * 128 + k1dg * 8) : *(const u32x4*)(P1 + (tk + k1key) * P1W + 640 + (k1dg - 8) * 8); \
        rv = *(const u32x4*)(KV + (tk + lane) * KVW + h * 128 + 64 + wave * 8); } while (0)
#define MLA_STORE(buf_, hf_) do { LAS bf16* Kl = (LAS bf16*)(lds + (buf_) * 45568) + (hf_) * 64 * 104; LAS bf16* Vl = (LAS bf16*)(lds + (buf_) * 45568 + 26624) + (hf_) * 64; \
        *(LAS u32x4*)(Kl + k0key * 104 + k0dg * 8) = rk0; if (tid < 256) *(LAS u32x4*)(Kl + k1key * 104 + k1dg * 8) = rk1; \
        Vl[(wave * 8 + 0) * 136 + lane] = (bf16)(rv.x & 0xffff); Vl[(wave * 8 + 1) * 136 + lane] = (bf16)(rv.x >> 16); Vl[(wave * 8 + 2) * 136 + lane] = (bf16)(rv.y & 0xffff); Vl[(wave * 8 + 3) * 136 + lane] = (bf16)(rv.y >> 16); \
        Vl[(wave * 8 + 4) * 136 + lane] = (bf16)(rv.z & 0xffff); Vl[(wave * 8 + 5) * 136 + lane] = (bf16)(rv.z >> 16); Vl[(wave * 8 + 6) * 136 + lane] = (bf16)(rv.w & 0xffff); Vl[(wave * 8 + 7) * 136 + lane] = (bf16)(rv.w >> 16); } while (0)
    MLA_LOAD(0, 0); MLA_STORE(0, 0); MLA_LOAD(0, 1); MLA_STORE(0, 1);
    __syncthreads();
#pragma unroll 1
    for (int kt = 0; kt < ntile; ++kt) {
        const int buf = kt & 1;
        const bool more = kt + 1 < ntile;
        if (more) MLA_LOAD(kt + 1, 0);
        const LAS bf16* Kl = (const LAS bf16*)(lds + buf * 45568); const LAS bf16* Vl = (const LAS bf16*)(lds + buf * 45568 + 26624);
#pragma unroll
        for (int hf = 0; hf < 2; ++hf) {
#pragma unroll 1
            for (int ksub = 2 * hf; ksub < 2 * hf + 2 && 4 * kt + ksub <= 2 * wdiag + 1; ++ksub) {
                f32x16 sc[2];
#pragma unroll
                for (int qs = 0; qs < 2; ++qs)
#pragma unroll
                    for (int i = 0; i < 16; ++i) sc[qs][i] = 0.f;
                bf16x8 kf[6];
#pragma unroll
                for (int ks = 0; ks < 6; ++ks) kf[ks] = *(const LAS bf16x8*)(Kl + (ksub * 32 + n32) * 104 + ks * 16 + hh * 8);
                __builtin_amdgcn_sched_barrier(0);
                __builtin_amdgcn_s_setprio(1);
#pragma unroll
                for (int ks = 0; ks < 6; ++ks) { sc[0] = MFMA32(kf[ks], qf[0][ks], sc[0]); sc[1] = MFMA32(kf[ks], qf[1][ks], sc[1]); }
                __builtin_amdgcn_s_setprio(0);
                s16x4 vlo[2][2], vhi[2][2];
#pragma unroll
                for (int s2 = 0; s2 < 2; ++s2)
#pragma unroll
                    for (int vt = 0; vt < 2; ++vt) { const LAS bf16* vp = Vl + (vt * 32 + n32) * 136 + ksub * 32 + 16 * s2 + 4 * hh; vlo[s2][vt] = *(const LAS s16x4*)vp; vhi[s2][vt] = *(const LAS s16x4*)(vp + 8); }
                if (4 * kt + ksub >= 2 * wdiag) { const int koff = (4 * kt + ksub - 2 * wdiag) * 32;
#pragma unroll
                    for (int qs = 0; qs < 2; ++qs)
#pragma unroll
                        for (int i = 0; i < 16; ++i) if (koff + crow32(i, hh) > qs * 32 + n32) sc[qs][i] = -INFINITY;
                }
#pragma unroll
                for (int qs = 0; qs < 2; ++qs) {
                    const float t0_ = fmaxf(fmaxf(sc[qs][0], sc[qs][1]), sc[qs][2]), t1_ = fmaxf(fmaxf(sc[qs][3], sc[qs][4]), sc[qs][5]), t2_ = fmaxf(fmaxf(sc[qs][6], sc[qs][7]), sc[qs][8]);
                    const float t3_ = fmaxf(fmaxf(sc[qs][9], sc[qs][10]), sc[qs][11]), t4_ = fmaxf(fmaxf(sc[qs][12], sc[qs][13]), sc[qs][14]);
                    float tm = fmaxf(fmaxf(fmaxf(t0_, t1_), t2_), fmaxf(fmaxf(t3_, t4_), sc[qs][15]));
                    tm = xor32_max(tm);
                    const float mold = mrun[qs], mnew = fmaxf(mold, tm);
                    mrun[qs] = mnew; f32x2 ps2 = {0.f, 0.f}, ps3 = {0.f, 0.f}; const f32x2 mn2 = {mnew, mnew};
#pragma unroll
                    for (int i = 0; i < 8; ++i) { f32x2 d = {sc[qs][2 * i], sc[qs][2 * i + 1]}; d = d - mn2;
                        f32x2 p; p.x = __builtin_amdgcn_exp2f(d.x); p.y = __builtin_amdgcn_exp2f(d.y); sc[qs][2 * i] = p.x; sc[qs][2 * i + 1] = p.y; if (i & 1) ps3 = ps3 + p; else ps2 = ps2 + p; }
                    const float ps = (ps2.x + ps2.y) + (ps3.x + ps3.y);
                    if (__builtin_amdgcn_ballot_w64(mnew > mold) != 0ull) {
                        const float alpha = __builtin_amdgcn_exp2f(mold - mnew);
                        lsum[qs] *= alpha;
#pragma unroll
                        for (int vt = 0; vt < 2; ++vt) oa[vt][qs] = oa[vt][qs] * alpha;
                    }
                    lsum[qs] += ps;
                }
#pragma unroll
                for (int s2 = 0; s2 < 2; ++s2) {
                    bf16x8 pf[2];
#pragma unroll
                    for (int qs = 0; qs < 2; ++qs) { u32x4 pw; pw.x = pk2(sc[qs][8 * s2 + 0], sc[qs][8 * s2 + 1]); pw.y = pk2(sc[qs][8 * s2 + 2], sc[qs][8 * s2 + 3]);
                        pw.z = pk2(sc[qs][8 * s2 + 4], sc[qs][8 * s2 + 5]); pw.w = pk2(sc[qs][8 * s2 + 6], sc[qs][8 * s2 + 7]); pf[qs] = __builtin_bit_cast(bf16x8, pw); }
#pragma unroll
                    for (int vt = 0; vt < 2; ++vt) {
                        const bf16x8 vf = __builtin_shufflevector(vlo[s2][vt], vhi[s2][vt], 0, 1, 2, 3, 4, 5, 6, 7);
                        oa[vt][0] = MFMA32(vf, pf[0], oa[vt][0]); oa[vt][1] = MFMA32(vf, pf[1], oa[vt][1]);
                    }
                }
            }
            if (more) { MLA_STORE(buf ^ 1, hf); if (hf == 0) MLA_LOAD(kt + 1, 1); }
        }
        __syncthreads();
    }
#undef MLA_LOAD
#undef MLA_STORE
#pragma unroll
    for (int qs = 0; qs < 2; ++qs) {
        float l = xor32_sum(lsum[qs]);
        const float inv = 1.f / l;
        bf16* Y = (bf16*)(ws + WS_Y) + (tb + q0 + qs * 32 + n32) * D_ + h * 64;
#pragma unroll
        for (int vt = 0; vt < 2; ++vt)
#pragma unroll
            for (int g4 = 0; g4 < 4; ++g4) { u32x2 w; w.x = pk2(oa[vt][qs][4 * g4] * inv, oa[vt][qs][4 * g4 + 1] * inv); w.y = pk2(oa[vt][qs][4 * g4 + 2] * inv, oa[vt][qs][4 * g4 + 3] * inv);
                *(u32x2*)(Y + vt * 32 + 8 * g4 + 4 * hh) = w; }
    }
}
#define XB_TMO      128
#define XB_XCNT(j)  (256  + 64 * (j))
#define XB_XSUB(j)  (1280 + 64 * (j))
#define XB_XGEN(j)  (2304 + 64 * (j))
#define XB_TOP      3328
#define XB_TOPGEN   3392
#define XCD_BAR_WORDS 3456
#define XB_SPIN_CAP (1u << 18)

__device__ __forceinline__ unsigned xb_ld(unsigned* p)              { return __hip_atomic_load(p, __ATOMIC_RELAXED, __HIP_MEMORY_SCOPE_AGENT); }
__device__ __forceinline__ unsigned xb_add(unsigned* p, unsigned v) { return __hip_atomic_fetch_add(p, v, __ATOMIC_RELAXED, __HIP_MEMORY_SCOPE_AGENT); }
__device__ __forceinline__ unsigned xb_xcc_id() { return (unsigned)__builtin_amdgcn_s_getreg((3 << 11) | 20) & 0xFu; }
#define XB_SPIN(cond, bar) do { unsigned _sp = 0; while (cond) { __builtin_amdgcn_s_sleep(1); \
    if ((++_sp & 255u) == 0u) { if (xb_ld(&(bar)[XB_TMO])) break; if (_sp > XB_SPIN_CAP) { atomicAdd(&(bar)[XB_TMO], 1u); break; } } } } while (0)

struct XcdBarrier {
    unsigned* bar; unsigned x;
    volatile LAS unsigned* st;
};

__device__ __forceinline__ XcdBarrier xcd_barrier_post(unsigned* bar, volatile LAS unsigned* st) {
    XcdBarrier b; b.bar = bar; b.x = xb_xcc_id(); b.st = st;
    if (threadIdx.x == 0) (void)xb_add(&bar[XB_XCNT(b.x)], 1u);
    return b;
}
__device__ __forceinline__ void xcd_barrier_complete(unsigned* bar, unsigned x, unsigned& nloc, unsigned& nx) {
    const unsigned G = gridDim.x * gridDim.y * gridDim.z;
    unsigned sum, cnt, mine, sp = 0u;
    for (;;) {
        sum = 0u; cnt = 0u; mine = 0u;
#pragma unroll
        for (unsigned j = 0; j < 16; ++j) { const unsigned c = xb_ld(&bar[XB_XCNT(j)]); sum += c; cnt += (c > 0u) ? 1u : 0u; mine = (j == x) ? c : mine; }
        if (sum == G) break;
        __builtin_amdgcn_s_sleep(1);
        if ((++sp & 255u) == 0u) { if (xb_ld(&bar[XB_TMO])) break; if (sp > XB_SPIN_CAP) { atomicAdd(&bar[XB_TMO], 1u); break; } }
    }
    nloc = mine > 0u ? mine : 1u; nx = cnt > 0u ? cnt : 1u;
}

__device__ __forceinline__ void xcd_barrier(const XcdBarrier& b) {
    asm volatile("s_waitcnt vmcnt(0)" ::: "memory");
    __syncthreads();
    if (threadIdx.x == 0) {
        unsigned* bar = b.bar;
        __builtin_amdgcn_s_waitcnt(0);
        unsigned nloc = b.st[0], nx = b.st[1];
        if (nloc == 0u) { xcd_barrier_complete(bar, b.x, nloc, nx); b.st[0] = nloc; b.st[1] = nx; }
        const unsigned old = xb_add(&bar[XB_XSUB(b.x)], 1u);
        const unsigned gen = old / nloc;
        if (old + 1u == (gen + 1u) * nloc) {
            __builtin_amdgcn_fence(__ATOMIC_RELEASE, "agent");
            asm volatile("s_waitcnt vmcnt(0)" ::: "memory");
            const unsigned og = xb_add(&bar[XB_TOP], 1u);
            const unsigned tg = og / nx;
            if (og + 1u == (tg + 1u) * nx) xb_add(&bar[XB_TOPGEN], 1u);
            else XB_SPIN(xb_ld(&bar[XB_TOPGEN]) == tg, bar);
            __builtin_amdgcn_fence(__ATOMIC_ACQUIRE, "agent");
            xb_add(&bar[XB_XGEN(b.x)], 1u);
            asm volatile("s_waitcnt vmcnt(0)" ::: "memory");
        } else {
            XB_SPIN(xb_ld(&bar[XB_XGEN(b.x)]) == gen, bar);
            __builtin_amdgcn_fence(__ATOMIC_ACQUIRE, "agent");
            asm volatile("s_waitcnt vmcnt(0)" ::: "memory");
        }
    }
    __syncthreads();
}

constexpr size_t WS_BAR = 7 * 131072 + 65536;
constexpr int LDS_BARST = LDS_BYTES - 64;
constexpr int NPHASE = 15;
static_assert(pg8::EP_CS == WS_CS && pg8::EP_MEMKV == WS_MEMKV && pg8::EP_XB == WS_XB && pg8::EP_BIG == WS_BIG && pg8::EP_T == T_ && WS_ROWSQ == 0, "epilogue constants");
__global__ void __launch_bounds__(NTHR, 2) fwd_mega(Args a) {
    extern __shared__ __attribute__((aligned(16))) unsigned char lds_raw[];
    LAS unsigned char* lds = (LAS unsigned char*)lds_raw;
    cg::grid_group grid = cg::this_grid();
    const int G = gridDim.x, bx = blockIdx.x;
#define TIDS int tid = threadIdx.x; asm volatile("" : "+v"(tid)); const int lane = tid & 63, wave = __builtin_amdgcn_readfirstlane(tid >> 6); int G_ = G; asm volatile("" : "+s"(G_)); const int gw = bx * NWAVES + wave, gt = bx * NTHR + tid, NGW = G_ * NWAVES, NGT = G_ * NTHR; (void)gw; (void)gt; (void)lane; (void)NGW; (void)NGT;
    for (int ph = a.ph_lo; ph < a.ph_hi; ++ph) {
        __attribute__((address_space(1))) unsigned char* wsg_ = (__attribute__((address_space(1))) unsigned char*)a.ws; asm volatile("" : "+s"(wsg_)); unsigned char* ws = (unsigned char*)wsg_;
        float* rowsq = (float*)(ws + WS_ROWSQ); (void)rowsq;
        bf16* XB = (bf16*)(ws + WS_XB); bf16* Yb = (bf16*)(ws + WS_Y); bf16* Hb = (bf16*)(ws + WS_BIG);
        bf16* P0 = (bf16*)(ws + WS_BIG); bf16* P1 = (bf16*)(ws + WS_BIG); bf16* Qb = (bf16*)(ws + WS_BIG + 64 * MiB); bf16* KVb = (bf16*)(ws + WS_BIG + 144 * MiB);
        const float* cs = (const float*)(ws + WS_CS);
        {
        int j0 = 0, j1 = 0;
        if (ph == 1) { j0 = 0; j1 = 2; } else if (ph == 5) { j0 = 2; j1 = 3; } else if (ph == 6) { j0 = 3; j1 = 4; } else if (ph == 7) { j0 = 4; j1 = 5; } else if (ph == 8) { j0 = 5; j1 = 6; }
        else if (ph == 9) { j0 = 6; j1 = 8; } else if (ph == 11) { j0 = 8; j1 = 9; } else if (ph == 12) { j0 = 9; j1 = 10; } else if (ph == 13) { j0 = 10; j1 = 11; }
        for (int job = j0; job < j1; ++job) {
            pg8::Gemm g; pg8::Epi e{job, ws, a};
            g.M = T_; g.lda = 1024; g.K = 1024; g.N = 1024; g.A = XB; g.Bt = nullptr;
            switch (job) {
                case 0: g.Bt = (const bf16*)(ws + WS_WIN0); g.N = P0W; break;
                case 1: g.A = (const bf16*)(ws + WS_MEMBF); g.Bt = (const bf16*)(ws + WS_WMEM); g.M = TM_; g.N = 512; break;
                case 2: g.A = Yb; g.Bt = (const bf16*)(ws + WS_WOUT0); break;
                case 3: g.Bt = (const bf16*)(ws + WS_WFF1_0); g.N = FF_; break;
                case 4: g.A = Hb; g.lda = FF_; g.K = FF_; g.Bt = (const bf16*)(ws + WS_WFF2_0); break;
                case 5: g.Bt = (const bf16*)(ws + WS_WIN1); break;
                case 6: g.A = P1 + 256; g.K = 384; g.Bt = (const bf16*)(ws + WS_WUQ); g.N = QW; break;
                case 7: g.A = P1; g.K = 256; g.Bt = (const bf16*)(ws + WS_WUKV); g.N = KVW; break;
                case 8: g.A = Yb; g.Bt = (const bf16*)(ws + WS_WOUT1); break;
                case 9: g.Bt = (const bf16*)(ws + WS_WFF1_1); g.N = FF_; break;
                default: g.A = Hb; g.lda = FF_; g.K = FF_; g.Bt = (const bf16*)(ws + WS_WFF2_1); break;
            }
            pg8::StaticOrder S; S.init(g.M, g.N, G, bx);
            pg8::gemm_phase<pg8::Epi, pg8::StaticOrder, true, true>(lds, g, S, e);
            __syncthreads();
        }
        if (ph == 0) { TIDS; p0_prologue(a, lds, gw, NGW, lane, wave, tid); }
        else if (ph == 2) { TIDS;
            for (int u = bx; u < 1024; u += G) mlstm_local_unit(a, lds, u, tid, lane, wave);
            for (int u = bx; u < 256; u += G) memattn_unit(a, lds, P0, P0W, 2304, u, tid, lane, wave);
        }
        else if (ph == 3) { TIDS; mlstm_scan(a, gt, NGT); }
        else if (ph == 4) { TIDS; mlstm_out_phase(a, lds, bx, G, tid); }
        else if (ph == 10) { TIDS;
            for (int r = 0; r * G < 768; ++r) { const int i = (G == 256 && r == 1) ? 511 - bx : r * G + bx; if (i < 768) { const int qb = 7 - i / 96, bh = i % 96; mla_unit(a, lds, bh / 12, bh % 12, qb, tid, lane, wave); } }
            for (int u = bx; u < 256; u += G) memattn_unit(a, lds, P1, P1W, 768, u, tid, lane, wave);
        }
        else if (ph == 14) { TIDS;
            const float* fg = inp(a, I_FINALNORM);
            for (int m0 = gw; m0 < T_; m0 += 4 * NGW) {
                f32x4 xv[4][4]; float rs[4];
                const f32x4 gv0 = ((const f32x4*)fg)[lane], gv1 = ((const f32x4*)fg)[64 + lane], gv2 = ((const f32x4*)fg)[128 + lane], gv3 = ((const f32x4*)fg)[192 + lane];
#pragma unroll
                for (int rr = 0; rr < 4; ++rr) { const int m = min(m0 + rr * NGW, T_ - 1); const f32x4* xr = (const f32x4*)(a.out + (size_t)m * D_) + lane; rs[rr] = rsqrtf(rowsq[4 * T_ + m] * (1.f / D_) + RMS_EPS);
#pragma unroll
                    for (int j = 0; j < 4; ++j) xv[rr][j] = xr[64 * j]; }
#pragma unroll
                for (int rr = 0; rr < 4; ++rr) { const int m = m0 + rr * NGW; if (m < T_) { f32x4* xw = (f32x4*)(a.out + (size_t)m * D_) + lane;
                        xw[0] = xv[rr][0] * rs[rr] * gv0; xw[64] = xv[rr][1] * rs[rr] * gv1; xw[128] = xv[rr][2] * rs[rr] * gv2; xw[192] = xv[rr][3] * rs[rr] * gv3; } }
            }
        }
        }
        if (ph + 1 < a.ph_hi) {
            if (a.ph_hi < 0) grid.sync();
            if (ph == a.ph_lo && threadIdx.x == 0) {
                volatile LAS unsigned* st_ = (volatile LAS unsigned*)(lds + LDS_BARST); st_[0] = 0u; st_[1] = 0u; (void)xb_add((unsigned*)(a.ws + WS_BAR) + XB_XCNT(xb_xcc_id()), 1u); }
            { XcdBarrier xb_; xb_.bar = (unsigned*)(a.ws + WS_BAR); xb_.x = xb_xcc_id(); xb_.st = (volatile LAS unsigned*)(lds + LDS_BARST); xcd_barrier(xb_); }
        }
    }
}

extern "C" void kernel_launch(void* const* d_in, const int* in_sizes, int n_in, void* d_out, int out_size, void* d_ws, size_t ws_size, hipStream_t stream) {
    static int grid = 0;
    if (grid == 0) {
        if (n_in != 26 || ws_size < WS_END || out_size != T_ * D_) { fprintf(stderr, "kernel_launch: unexpected problem (n_in %d, ws %zu, out %d)\n", n_in, ws_size, out_size); grid = -1; return; }
        int dev = 0, cus = 0, per_cu = 0;
        (void)hipGetDevice(&dev); (void)hipDeviceGetAttribute(&cus, hipDeviceAttributeMultiprocessorCount, dev);
        if (hipFuncSetAttribute((const void*)fwd_mega, hipFuncAttributeMaxDynamicSharedMemorySize, LDS_BYTES) != hipSuccess) { fprintf(stderr, "kernel_launch: hipFuncSetAttribute failed\n"); grid = -1; return; }
        if (hipOccupancyMaxActiveBlocksPerMultiprocessor(&per_cu, (const void*)fwd_mega, NTHR, LDS_BYTES) != hipSuccess || per_cu < 1) { fprintf(stderr, "kernel_launch: occupancy query gave %d\n", per_cu); per_cu = 1; }
        (void)hipGetLastError();
        grid = cus * per_cu;
        fprintf(stderr, "kernel_launch: grid %d (cus %d x %d)\n", grid, cus, per_cu);
    }
    if (grid < 0) return;
    if (!MK_MULTI) (void)hipMemsetAsync((unsigned char*)d_ws + WS_BAR, 0, 16384, stream);
    Args a{};
    for (int i = 0; i < 26; ++i) a.in[i] = (const float*)d_in[i];
    a.out = (float*)d_out; a.ws = (unsigned char*)d_ws;
#if MK_MULTI
    for (int ph = 0; ph < NPHASE; ++ph) { a.ph_lo = ph; a.ph_hi = ph + 1; hipLaunchKernelGGL(fwd_mega, dim3(grid), dim3(NTHR), LDS_BYTES, stream, a); }
#else
    a.ph_lo = 0; a.ph_hi = NPHASE;
    void* args[] = {&a};
    hipError_t e = hipLaunchCooperativeKernel((const void*)fwd_mega, dim3(grid), dim3(NTHR), args, LDS_BYTES, stream);
    if (e != hipSuccess) fprintf(stderr, "kernel_launch: cooperative launch failed: %s (grid %d)\n", hipGetErrorString(e), grid);
#endif
}
```
